# Optimizing an MI355X kernel written in HIP

```python
import math
import jax
import jax.numpy as jnp
from jax import lax
import numpy as np

D_MODEL = 1024
BATCH = 2
SEQ = 16384
DEPTH = 2

GRID_W = 64
CTX_LEN = 256
HEAD_DIM = 64
ROPE_THETA = 10000.0
NORM_EPS = 1e-6
NEG_INF = -1e30

A_HEADS = 4
A_VDIM = 2 * HEAD_DIM
A_WIDTH = A_HEADS * A_VDIM
Q_BLOCK = 128

B_KV_HEADS = 2
B_GROUP = 4
B_WIDTH = B_KV_HEADS * B_GROUP * HEAD_DIM
B_KV_WIDTH = B_KV_HEADS * HEAD_DIM
WINDOW = 128
WIN_BLOCK = 128

C_HEADS = 8
C_WIDTH = C_HEADS * HEAD_DIM
NA_ROWS = 8
NA_COLS = 16
NA_COL_BLOCK = 16
NA_COL_SPAN = NA_COL_BLOCK + NA_COLS

D_HEADS = 8
D_HEAD = 64
D_WIDTH = D_HEADS * D_HEAD
D_DECAY_LORA = 32
D_ICL_LORA = 32
D_GATE_LORA = 96
D_GN_EPS = 64e-5

D_FF = ((8 * D_MODEL + 3 * 256 - 1) // (3 * 256)) * 256

AB_SPLITS = (A_WIDTH, 2 * A_WIDTH, 3 * A_WIDTH, 3 * A_WIDTH + B_WIDTH, 3 * A_WIDTH + B_WIDTH + B_KV_WIDTH)
AB_IN = 3 * A_WIDTH + B_WIDTH + 2 * B_KV_WIDTH
AB_OUT = A_WIDTH + B_WIDTH
D_SPLITS = (D_WIDTH, 2 * D_WIDTH, 3 * D_WIDTH, 3 * D_WIDTH + 2 * D_DECAY_LORA, 3 * D_WIDTH + 2 * D_DECAY_LORA + 2 * D_ICL_LORA)
D_COLS = 3 * D_WIDTH + 2 * D_DECAY_LORA + 2 * D_ICL_LORA + D_GATE_LORA
CD_IN = 3 * C_WIDTH + D_COLS
CD_OUT = C_WIDTH + D_WIDTH

kernel_name = 'hybrid_diffattn_window_natten_rwkv7_prefix'


def rms_norm(x, gain):
    xf = x.astype(jnp.float32)
    y = xf * lax.rsqrt(jnp.mean(xf * xf, axis=-1, keepdims=True) + NORM_EPS)
    return (y * gain.astype(jnp.float32)).astype(x.dtype)


def modulate(h, shift, scale):
    return h * (1.0 + scale) + shift


def swiglu(h, w_gate, w_up, w_down):
    return (jax.nn.silu(h @ w_gate) * (h @ w_up)) @ w_down


def axial_rope_tables(n_tokens):
    axis_dim = HEAD_DIM // 2
    freqs = ROPE_THETA ** (-jnp.arange(0, axis_dim, 2, dtype=jnp.float32) / axis_dim)
    t = jnp.arange(n_tokens, dtype=jnp.int32)
    ang_r = (t // GRID_W).astype(jnp.float32)[:, None] * freqs
    ang_c = (t % GRID_W).astype(jnp.float32)[:, None] * freqs
    return (jnp.cos(ang_r), jnp.sin(ang_r), jnp.cos(ang_c), jnp.sin(ang_c))


def _rotate_half(x, cos, sin):
    x1, x2 = jnp.split(x, 2, axis=-1)
    return jnp.concatenate([x1 * cos - x2 * sin, x2 * cos + x1 * sin], axis=-1)


def apply_axial_rope(x, tables):
    shape = (x.shape[1],) + (1,) * (x.ndim - 3) + (tables[0].shape[-1],)
    cr, sr, cc, sc = [tb.reshape(shape) for tb in tables]
    half = x.shape[-1] // 2
    xf = x.astype(jnp.float32)
    out = jnp.concatenate([_rotate_half(xf[..., :half], cr, sr), _rotate_half(xf[..., half:], cc, sc)], axis=-1)
    return out.astype(x.dtype)


def _diff_softmax_attend(q, k, v, lam):
    s = jnp.einsum('bqhcd,bkhcd->bhcqk', q, k, preferred_element_type=jnp.float32) * (HEAD_DIM ** -0.5)
    p = jax.nn.softmax(s, axis=-1)
    attn = p[:, :, 0] - lam * p[:, :, 1]
    return jnp.einsum('bhqk,bkhe->bqhe', attn, v.astype(jnp.float32))


def _diff_post(o, subln, lambda_init):
    b, t = o.shape[:2]
    return (rms_norm(o, subln) * (1.0 - lambda_init)).reshape(b, t, A_WIDTH)


def differential_attention(q, k, v, k_ctx, v_ctx, lam, subln, lambda_init):
    b, s_len = q.shape[:2]
    nb = s_len // Q_BLOCK
    k_all = jnp.concatenate([k_ctx, k], axis=1)
    v_all = jnp.concatenate([v_ctx, v], axis=1)
    qb = jnp.moveaxis(q.reshape(b, nb, Q_BLOCK, A_HEADS, 2, HEAD_DIM), 1, 0)
    o = lax.map(lambda blk: _diff_softmax_attend(blk, k_all, v_all, lam), qb)
    o = jnp.moveaxis(o, 0, 1).reshape(b, s_len, A_HEADS, A_VDIM)
    return _diff_post(o, subln, lambda_init)


def windowed_gqa_sink(q, k, v, k_ctx, v_ctx, sink):
    b, s_len, g, j, d = q.shape
    nb = s_len // WIN_BLOCK
    scale = d ** -0.5
    sink_l = sink.astype(jnp.float32).reshape(1, g, j, 1, 1)

    def band(t):
        tp = jnp.pad(t, ((0, 0), (WIN_BLOCK, WIN_BLOCK), (0, 0), (0, 0))).reshape(b, nb + 2, WIN_BLOCK, g, d)
        tb = jnp.concatenate([tp[:, :-2], tp[:, 1:-1], tp[:, 2:]], axis=2)
        return jnp.moveaxis(tb, 1, 0)

    q_blocks = jnp.moveaxis(q.reshape(b, nb, WIN_BLOCK, g, j, d), 1, 0)
    q_offs = jnp.arange(WIN_BLOCK)
    k_offs = jnp.arange(3 * WIN_BLOCK) - WIN_BLOCK
    n_win = 3 * WIN_BLOCK
    n_ctx = k_ctx.shape[1]

    def block(args):
        qb, kb, vb, bi = args
        qpos = bi * WIN_BLOCK + q_offs
        kpos = bi * WIN_BLOCK + k_offs
        valid = (kpos >= 0)[None, :] & (kpos < s_len)[None, :] & (jnp.abs(qpos[:, None] - kpos[None, :]) <= WINDOW)
        s_win = jnp.einsum('bqgjd,bkgd->bgjqk', qb, kb, preferred_element_type=jnp.float32) * scale
        s_win = jnp.where(valid, s_win, NEG_INF)
        s_ctx = jnp.einsum('bqgjd,bkgd->bgjqk', qb, k_ctx, preferred_element_type=jnp.float32) * scale
        s_snk = jnp.broadcast_to(sink_l, s_win.shape[:-1] + (1,))
        p = jax.nn.softmax(jnp.concatenate([s_win, s_ctx, s_snk], axis=-1), axis=-1)
        o = jnp.einsum('bgjqk,bkgd->bqgjd', p[..., :n_win], vb.astype(jnp.float32))
        return o + jnp.einsum('bgjqk,bkgd->bqgjd', p[..., n_win:n_win + n_ctx], v_ctx.astype(jnp.float32))

    o = lax.map(block, (q_blocks, band(k), band(v), jnp.arange(nb)))
    return jnp.moveaxis(o, 0, 1).reshape(b, s_len, g * j * d)


def sink_ctx_attention(q, k, v, sink):
    b, t, g, j, d = q.shape
    s = jnp.einsum('bqgjd,bkgd->bgjqk', q, k, preferred_element_type=jnp.float32) * (d ** -0.5)
    snk = jnp.broadcast_to(sink.astype(jnp.float32).reshape(1, g, j, 1, 1), s.shape[:-1] + (1,))
    p = jax.nn.softmax(jnp.concatenate([s, snk], axis=-1), axis=-1)[..., :-1]
    return jnp.einsum('bgjqk,bkgd->bqgjd', p, v.astype(jnp.float32)).reshape(b, t, g * j * d)


def neighbourhood_attention(q, k, v, k_ctx, v_ctx, rpb):
    b, s_len, h, d = q.shape
    rows = s_len // GRID_W
    kr = min(NA_ROWS, rows)
    n_cb = GRID_W // NA_COL_BLOCK
    scale = d ** -0.5
    qg = q.reshape(b, rows, GRID_W, h, d)
    kg = k.reshape(b, rows, GRID_W, h, d)
    vg = v.reshape(b, rows, GRID_W, h, d)
    qcol = np.arange(GRID_W).reshape(n_cb, NA_COL_BLOCK)
    c0 = np.clip(np.arange(n_cb) * NA_COL_BLOCK - NA_COLS // 2, 0, GRID_W - NA_COL_SPAN)
    kcol = c0[:, None] + np.arange(NA_COL_SPAN)
    cstart = np.clip(qcol - NA_COLS // 2, 0, GRID_W - NA_COLS)
    in_win = (kcol[:, None, :] >= cstart[:, :, None]) & (kcol[:, None, :] < cstart[:, :, None] + NA_COLS)
    col_idx = np.clip(kcol[:, None, :] - qcol[:, :, None], 1 - NA_COLS, NA_COLS - 1) + NA_COLS - 1
    mask = np.broadcast_to(in_win[:, :, None, :], (n_cb, NA_COL_BLOCK, kr, NA_COL_SPAN)).reshape(n_cb, NA_COL_BLOCK, kr * NA_COL_SPAN)
    rpb_f = rpb.astype(jnp.float32)
    n_nb = kr * NA_COL_SPAN

    def gather_rows(t_grid, r0):
        rows_blk = lax.dynamic_slice_in_dim(t_grid, r0, kr, axis=1)
        blk = rows_blk[:, :, kcol]
        return jnp.moveaxis(blk, 2, 1).reshape(b, n_cb, n_nb, h, d)

    def row(i):
        r0 = jnp.clip(i - kr // 2, 0, rows - kr)
        qi = lax.dynamic_index_in_dim(qg, i, axis=1, keepdims=False).reshape(b, n_cb, NA_COL_BLOCK, h, d)
        ki = gather_rows(kg, r0)
        vi = gather_rows(vg, r0)
        row_idx = r0 + jnp.arange(kr) - i + NA_ROWS - 1
        bias = rpb_f[:, row_idx[None, None, :, None], col_idx[:, :, None, :]].reshape(h, n_cb, NA_COL_BLOCK, n_nb)
        s_nb = jnp.einsum('bmqhd,bmkhd->bhmqk', qi, ki, preferred_element_type=jnp.float32) * scale + bias
        s_nb = jnp.where(mask, s_nb, NEG_INF)
        s_cx = jnp.einsum('bmqhd,bkhd->bhmqk', qi, k_ctx, preferred_element_type=jnp.float32) * scale
        p = jax.nn.softmax(jnp.concatenate([s_nb, s_cx], axis=-1), axis=-1)
        o = jnp.einsum('bhmqk,bmkhd->bmqhd', p[..., :n_nb], vi.astype(jnp.float32))
        o = o + jnp.einsum('bhmqk,bkhd->bmqhd', p[..., n_nb:], v_ctx.astype(jnp.float32))
        return o.reshape(b, GRID_W, h, d)

    o = lax.map(row, jnp.arange(rows))
    return jnp.moveaxis(o, 0, 1).reshape(b, s_len, h * d)


def ctx_softmax_attention(q, k, v):
    b, t, h, d = q.shape
    s = jnp.einsum('bqhd,bkhd->bhqk', q, k, preferred_element_type=jnp.float32) * (d ** -0.5)
    return jnp.einsum('bhqk,bkhd->bqhd', jax.nn.softmax(s, axis=-1), v.astype(jnp.float32)).reshape(b, t, h * d)


def _bidir_token_shift(x, mu):
    prev = jnp.pad(x[:, :-1], ((0, 0), (1, 0), (0, 0)))
    nxt = jnp.pad(x[:, 1:], ((0, 0), (0, 1), (0, 0)))
    return x + mu * (0.5 * (prev + nxt) - x)


def _rwkv7_prepare(cols, mu, w0, w2, a0, a2, g2, k_k, k_a):
    b, t, _ = cols.shape
    xs = _bidir_token_shift(cols.astype(jnp.float32), mu.astype(jnp.float32))
    r, k, v, wd, ad, gd = jnp.split(xs, D_SPLITS, axis=-1)
    wd = wd.reshape(b, t, 2, D_DECAY_LORA)
    ad = ad.reshape(b, t, 2, D_ICL_LORA)
    w = -jax.nn.softplus(-(w0 + jnp.einsum('btzl,zlc->btzc', jnp.tanh(wd), w2))) - 0.5
    a = jax.nn.sigmoid(a0 + jnp.einsum('btzl,zlc->btzc', ad, a2))
    g = jax.nn.sigmoid(gd) @ g2
    kk = (k * k_k).reshape(b, t, D_HEADS, D_HEAD)
    kk = kk / jnp.maximum(jnp.sqrt(jnp.sum(kk * kk, axis=-1, keepdims=True)), 1e-12)
    k_dir = k[:, :, None, :] * (1.0 + (a - 1.0) * k_a)

    def heads(z):
        return jnp.moveaxis(z.reshape(b, t, 2, D_HEADS, D_HEAD), 2, 0)

    r_h = r.reshape(b, t, D_HEADS, D_HEAD)
    v_h = v.reshape(b, t, D_HEADS, D_HEAD)
    return r_h, heads(k_dir), v_h, heads(jnp.exp(-jnp.exp(w))), kk, heads(a), g


def _rwkv7_scan(r, decay, k, v, a, b, s0):
    xs = tuple(jnp.moveaxis(z, 2, 0) for z in (r, decay, k, v, a, b))

    def step(s, inp):
        r_t, w_t, k_t, v_t, a_t, b_t = inp
        sa = jnp.einsum('zbhvk,zbhk->zbhv', s, a_t)
        s = s * w_t[..., None, :] + sa[..., :, None] * b_t[..., None, :] + v_t[..., :, None] * k_t[..., None, :]
        return s, jnp.einsum('zbhvk,zbhk->zbhv', s, r_t)

    s_fin, ys = lax.scan(step, s0, xs)
    return s_fin, jnp.moveaxis(ys, 0, 2)


def _orient(z):
    return jnp.concatenate([z[:1], jnp.flip(z[1:], axis=2)], axis=0)


def _rwkv7_bidir_scan(r_h, k_dir, v_h, decay, kk, a_h, s0):
    inputs = (jnp.stack([r_h, r_h]), decay, k_dir, jnp.stack([v_h, v_h]), jnp.stack([-kk, -kk]), kk[None] * a_h)
    s_fin, y = _rwkv7_scan(*[_orient(z) for z in inputs], s0)
    return s_fin, _orient(y)


def _rwkv7_output(y, r_h, k_dir, v_h, g, r_k, ln_w, ln_b):
    b, t = r_h.shape[:2]
    y = jnp.sum(y, axis=0)
    mean = jnp.mean(y, axis=-1, keepdims=True)
    var = jnp.mean(jnp.square(y - mean), axis=-1, keepdims=True)
    yn = ((y - mean) * lax.rsqrt(var + D_GN_EPS)).reshape(b, t, D_WIDTH) * ln_w + ln_b
    bonus = jnp.sum(jnp.sum(r_h[None] * k_dir * r_k, axis=-1, keepdims=True) * v_h[None], axis=0)
    return (yn + bonus.reshape(b, t, D_WIDTH)) * g


def ab_mixer(h_lat, h_ctx, w_in, w_out, a_qn, a_kn, a_lam, a_subln, b_qn, b_kn, b_sink, rope, lambda_init, need_ctx):
    def split(p):
        b, t, _ = p.shape
        aq, ak, av, bq, bk, bv = jnp.split(p, AB_SPLITS, axis=-1)
        aq = rms_norm(aq.reshape(b, t, A_HEADS, 2, HEAD_DIM), a_qn)
        ak = rms_norm(ak.reshape(b, t, A_HEADS, 2, HEAD_DIM), a_kn)
        av = av.reshape(b, t, A_HEADS, A_VDIM)
        bq = rms_norm(bq.reshape(b, t, B_KV_HEADS, B_GROUP, HEAD_DIM), b_qn)
        bk = rms_norm(bk.reshape(b, t, B_KV_HEADS, HEAD_DIM), b_kn)
        bv = bv.reshape(b, t, B_KV_HEADS, HEAD_DIM)
        return aq, ak, av, bq, bk, bv

    aq, ak, av, bq, bk, bv = split(h_lat @ w_in)
    aq, ak, bq, bk = [apply_axial_rope(z, rope) for z in (aq, ak, bq, bk)]
    aq_c, ak_c, av_c, bq_c, bk_c, bv_c = split(h_ctx @ w_in)
    lam_f = a_lam.astype(jnp.float32)
    lam = jnp.exp(jnp.sum(lam_f[0] * lam_f[1])) - jnp.exp(jnp.sum(lam_f[2] * lam_f[3])) + lambda_init
    a_lat = differential_attention(aq, ak, av, ak_c, av_c, lam, a_subln, lambda_init)
    b_lat = windowed_gqa_sink(bq, bk, bv, bk_c, bv_c, b_sink)
    o_lat = jnp.concatenate([a_lat, b_lat], axis=-1).astype(h_lat.dtype) @ w_out
    if not need_ctx:
        return o_lat, None
    a_ctx = _diff_post(_diff_softmax_attend(aq_c, ak_c, av_c, lam), a_subln, lambda_init)
    b_ctx = sink_ctx_attention(bq_c, bk_c, bv_c, b_sink)
    o_ctx = jnp.concatenate([a_ctx, b_ctx], axis=-1).astype(h_ctx.dtype) @ w_out
    return o_lat, o_ctx


def cd_mixer(h_lat, h_ctx, w_in, w_out, c_qn, c_kn, c_rpb, d_mu, d_w0, d_w2, d_a0, d_a2, d_g2, d_k_k, d_k_a, d_r_k, d_ln_w, d_ln_b, need_ctx):
    def split(p):
        b, t, _ = p.shape
        cq, ck, cv, dcols = jnp.split(p, (C_WIDTH, 2 * C_WIDTH, 3 * C_WIDTH), axis=-1)
        cq = rms_norm(cq.reshape(b, t, C_HEADS, HEAD_DIM), c_qn)
        ck = rms_norm(ck.reshape(b, t, C_HEADS, HEAD_DIM), c_kn)
        return cq, ck, cv.reshape(b, t, C_HEADS, HEAD_DIM), dcols

    cq, ck, cv, d_lat_cols = split(h_lat @ w_in)
    cq_c, ck_c, cv_c, d_ctx_cols = split(h_ctx @ w_in)
    c_lat = neighbourhood_attention(cq, ck, cv, ck_c, cv_c, c_rpb)

    prep_c = _rwkv7_prepare(d_ctx_cols, d_mu, d_w0, d_w2, d_a0, d_a2, d_g2, d_k_k, d_k_a)
    prep_l = _rwkv7_prepare(d_lat_cols, d_mu, d_w0, d_w2, d_a0, d_a2, d_g2, d_k_k, d_k_a)
    s0 = jnp.zeros((2, h_lat.shape[0], D_HEADS, D_HEAD, D_HEAD), jnp.float32)
    s_ctx, y_ctx = _rwkv7_bidir_scan(*prep_c[:6], s0)
    _, y_lat = _rwkv7_bidir_scan(*prep_l[:6], s_ctx)
    d_lat = _rwkv7_output(y_lat, prep_l[0], prep_l[1], prep_l[2], prep_l[6], d_r_k, d_ln_w, d_ln_b)
    o_lat = jnp.concatenate([c_lat, d_lat], axis=-1).astype(h_lat.dtype) @ w_out
    if not need_ctx:
        return o_lat, None
    c_ctx_o = ctx_softmax_attention(cq_c, ck_c, cv_c)
    d_ctx_o = _rwkv7_output(y_ctx, prep_c[0], prep_c[1], prep_c[2], prep_c[6], d_r_k, d_ln_w, d_ln_b)
    o_ctx = jnp.concatenate([c_ctx_o, d_ctx_o], axis=-1).astype(h_ctx.dtype) @ w_out
    return o_lat, o_ctx


def setup_inputs(seed: int = 0) -> dict:
    key = jax.random.key(seed)
    ks = list(jax.random.split(key, 40))
    n_ab = (DEPTH + 1) // 2
    n_cd = DEPTH // 2

    def nrm(idx, shape, scale):
        return jax.random.normal(ks[idx], shape, jnp.float32) * scale

    return {
        'x': nrm(0, (BATCH, SEQ, D_MODEL), 1.0),
        'c': nrm(1, (BATCH, D_MODEL), 1.0),
        'ctx': nrm(2, (BATCH, CTX_LEN, D_MODEL), 1.0),
        'c_ctx': nrm(3, (D_MODEL,), 1.0),
        'ada_w': nrm(4, (DEPTH, D_MODEL, 6 * D_MODEL), 0.5 * D_MODEL ** -0.5),
        'ada_b': nrm(5, (DEPTH, 6 * D_MODEL), 0.02),
        'norm_mix': 1.0 + nrm(6, (DEPTH, D_MODEL), 0.02),
        'norm_ffn': 1.0 + nrm(7, (DEPTH, D_MODEL), 0.02),
        'ffn_w_gate': nrm(8, (DEPTH, D_MODEL, D_FF), D_MODEL ** -0.5),
        'ffn_w_up': nrm(9, (DEPTH, D_MODEL, D_FF), D_MODEL ** -0.5),
        'ffn_w_down': nrm(10, (DEPTH, D_FF, D_MODEL), D_FF ** -0.5),
        'ab_w_in': nrm(11, (n_ab, D_MODEL, AB_IN), D_MODEL ** -0.5),
        'ab_w_out': nrm(12, (n_ab, AB_OUT, D_MODEL), AB_OUT ** -0.5),
        'a_q_norm': 1.0 + nrm(13, (n_ab, HEAD_DIM), 0.02),
        'a_k_norm': 1.0 + nrm(14, (n_ab, HEAD_DIM), 0.02),
        'a_lambda': nrm(15, (n_ab, 4, HEAD_DIM), 0.1),
        'a_subln': 1.0 + nrm(16, (n_ab, A_VDIM), 0.02),
        'b_q_norm': 1.0 + nrm(17, (n_ab, HEAD_DIM), 0.02),
        'b_k_norm': 1.0 + nrm(18, (n_ab, HEAD_DIM), 0.02),
        'b_sink': nrm(19, (n_ab, B_KV_HEADS * B_GROUP), 1.0),
        'cd_w_in': nrm(20, (n_cd, D_MODEL, CD_IN), D_MODEL ** -0.5),
        'cd_w_out': nrm(21, (n_cd, CD_OUT, D_MODEL), CD_OUT ** -0.5),
        'c_q_norm': 1.0 + nrm(22, (n_cd, HEAD_DIM), 0.02),
        'c_k_norm': 1.0 + nrm(23, (n_cd, HEAD_DIM), 0.02),
        'c_rpb': nrm(24, (n_cd, C_HEADS, 2 * NA_ROWS - 1, 2 * NA_COLS - 1), 0.5),
        'd_mu': jax.random.uniform(ks[25], (n_cd, D_COLS), jnp.float32, 0.0, 1.0),
        'd_w0': jax.random.uniform(ks[26], (n_cd, 2, D_WIDTH), jnp.float32, -6.0, 1.0),
        'd_w2': nrm(27, (n_cd, 2, D_DECAY_LORA, D_WIDTH), 0.1),
        'd_a0': nrm(28, (n_cd, 2, D_WIDTH), 0.5),
        'd_a2': nrm(29, (n_cd, 2, D_ICL_LORA, D_WIDTH), 0.1),
        'd_g2': nrm(30, (n_cd, D_GATE_LORA, D_WIDTH), D_GATE_LORA ** -0.5),
        'd_k_k': 0.85 + nrm(31, (n_cd, D_WIDTH), 0.02),
        'd_k_a': 1.0 + nrm(32, (n_cd, D_WIDTH), 0.02),
        'd_r_k': nrm(33, (n_cd, D_HEADS, D_HEAD), 0.1),
        'd_ln_w': 1.0 + nrm(34, (n_cd, D_WIDTH), 0.02),
        'd_ln_b': nrm(35, (n_cd, D_WIDTH), 0.02),
    }


def reference(x, c, ctx, c_ctx, ada_w, ada_b, norm_mix, norm_ffn, ffn_w_gate, ffn_w_up, ffn_w_down,
              ab_w_in, ab_w_out, a_q_norm, a_k_norm, a_lambda, a_subln, b_q_norm, b_k_norm, b_sink,
              cd_w_in, cd_w_out, c_q_norm, c_k_norm, c_rpb, d_mu, d_w0, d_w2, d_a0, d_a2, d_g2,
              d_k_k, d_k_a, d_r_k, d_ln_w, d_ln_b):
    rope = axial_rope_tables(x.shape[1])
    cond_lat = jax.nn.silu(c)[:, None, :]
    cond_ctx = jax.nn.silu(c_ctx)
    x_lat, x_ctx = x, ctx
    for layer in range(DEPTH):
        need_ctx = layer < DEPTH - 1
        i = layer // 2
        sh_l, sc_l, g_l, fsh_l, fsc_l, fg_l = jnp.split(cond_lat @ ada_w[layer] + ada_b[layer], 6, axis=-1)
        sh_c, sc_c, g_c, fsh_c, fsc_c, fg_c = jnp.split(cond_ctx @ ada_w[layer] + ada_b[layer], 6, axis=-1)
        h_lat = modulate(rms_norm(x_lat, norm_mix[layer]), sh_l, sc_l)
        h_ctx = modulate(rms_norm(x_ctx, norm_mix[layer]), sh_c, sc_c)
        if layer % 2 == 0:
            lambda_init = 0.8 - 0.6 * math.exp(-0.3 * layer)
            o_lat, o_ctx = ab_mixer(h_lat, h_ctx, ab_w_in[i], ab_w_out[i], a_q_norm[i], a_k_norm[i], a_lambda[i],
                                    a_subln[i], b_q_norm[i], b_k_norm[i], b_sink[i], rope, lambda_init, need_ctx)
        else:
            o_lat, o_ctx = cd_mixer(h_lat, h_ctx, cd_w_in[i], cd_w_out[i], c_q_norm[i], c_k_norm[i], c_rpb[i],
                                    d_mu[i], d_w0[i], d_w2[i], d_a0[i], d_a2[i], d_g2[i], d_k_k[i], d_k_a[i],
                                    d_r_k[i], d_ln_w[i], d_ln_b[i], need_ctx)
        x_lat = x_lat + g_l * o_lat
        x_lat = x_lat + fg_l * swiglu(modulate(rms_norm(x_lat, norm_ffn[layer]), fsh_l, fsc_l),
                                      ffn_w_gate[layer], ffn_w_up[layer], ffn_w_down[layer])
        if need_ctx:
            x_ctx = x_ctx + g_c * o_ctx
            x_ctx = x_ctx + fg_c * swiglu(modulate(rms_norm(x_ctx, norm_ffn[layer]), fsh_c, fsc_c),
                                          ffn_w_gate[layer], ffn_w_up[layer], ffn_w_down[layer])
    return x_lat
```

```cpp
#include <hip/hip_runtime.h>
#include <hip/hip_cooperative_groups.h>
#include <stdint.h>
#include <stdio.h>

namespace cg = cooperative_groups;

#ifndef MEGA
#define MEGA 1
#endif
#define DUP_MASK 0

typedef unsigned short bf16_t;
typedef short bf16x8 __attribute__((ext_vector_type(8)));
typedef short bf16x4 __attribute__((ext_vector_type(4)));
typedef float f32x4 __attribute__((ext_vector_type(4)));
typedef float f32x2 __attribute__((ext_vector_type(2)));

#define DM 1024
#define TPB 16640
#define MROWS 33280
#define DFF 2816
#define LOG2E 1.4426950408889634f
#define LSTR 80

#define OFF_WIN   0ull
#define OFF_WOUT  6815744ull
#define OFF_WGU   8912896ull
#define OFF_WDN   20447232ull
#define OFF_MISC  26214400ull
#define OFF_MOD   (OFF_MISC)
#define OFF_ROPE  (OFF_MISC + 147456ull)
#define OFF_LAM   (OFF_MISC + 180224ull)
#define OFF_BAR   (OFF_MISC + 196608ull)
#define OFF_XCTX  (OFF_MISC + 262144ull)
#define OFF_WL    (OFF_MISC + 2359296ull)
#define OFF_A     (OFF_MISC + 4194304ull)
#define OFF_BIG   (OFF_A + 68157440ull)
#define SZ512     34078720ull
#define OFF_AQ    (OFF_BIG)
#define OFF_AK    (OFF_BIG + SZ512)
#define OFF_AVT   (OFF_BIG + 2 * SZ512)
#define OFF_BQ    (OFF_BIG + 3 * SZ512)
#define OFF_BK    (OFF_BIG + 4 * SZ512)
#define OFF_BVT   (OFF_BK + 8519680ull)
#define OFF_ACT   (OFF_BIG)
#define OFF_RAW   (OFF_BIG)
#define OFF_LORA  (OFF_BIG + 102236160ull)
#define OFF_D0    (OFF_BIG + 132055040ull)
#define OFF_CQ    (OFF_D0)
#define OFF_CK    (OFF_D0 + SZ512)
#define OFF_CVT   (OFF_D0 + 2 * SZ512)
#define OFF_XR    (OFF_D0)
#define OFF_XK    (OFF_D0 + 1 * SZ512)
#define OFF_XV    (OFF_D0 + 2 * SZ512)
#define OFF_KK    (OFF_D0 + 3 * SZ512)
#define OFF_DP    (OFF_D0 + 4 * SZ512)
#define OFF_AZ    (OFF_D0 + 6 * SZ512)
#define OFF_YZ    (OFF_BIG)
#define WS_NEEDED (OFF_D0 + 8 * SZ512)

struct Params {
  const float *x, *c, *ctx, *c_ctx, *ada_w, *ada_b, *norm_mix, *norm_ffn, *w_gate, *w_up, *w_down,
      *ab_w_in, *ab_w_out, *a_qn, *a_kn, *a_lambda, *a_subln, *b_qn, *b_kn, *b_sink,
      *cd_w_in, *cd_w_out, *c_qn, *c_kn, *c_rpb, *d_mu, *d_w0, *d_w2, *d_a0, *d_a2, *d_g2,
      *d_k_k, *d_k_a, *d_r_k, *d_ln_w, *d_ln_b;
  float* out;
  char* ws;
};

__device__ __forceinline__ bf16_t f2bf(float f) {
  uint32_t u = __float_as_uint(f);
  u += 0x7fffu + ((u >> 16) & 1u);
  return (bf16_t)(u >> 16);
}
__device__ __forceinline__ float bf2f(bf16_t h) { return __uint_as_float(((uint32_t)h) << 16); }
typedef __bf16 bf16v2_t __attribute__((ext_vector_type(2)));
__device__ __forceinline__ uint32_t pack2(float a, float b) {
  const f32x2 v = (f32x2){a, b};
  const bf16v2_t r = __builtin_convertvector(v, bf16v2_t);
  return __builtin_bit_cast(uint32_t, r);
}
__device__ __forceinline__ float fexp2(float x) { return __builtin_amdgcn_exp2f(x); }
__device__ __forceinline__ float wave_sum(float v) {
#pragma unroll
  for (int o = 32; o >= 1; o >>= 1) v += __shfl_xor(v, o);
  return v;
}
__device__ __forceinline__ float sigmoidf_(float x) { return __builtin_amdgcn_rcpf(1.0f + __expf(-x)); }

template <bool DEEP, class Epi>
__device__ __forceinline__ void gemm_phase(const bf16_t* __restrict__ A, int lda, const bf16_t* __restrict__ Wt,
                                           int K, int ntn, bool lat_only, const Epi& epi, char* smem) {
  bf16_t* sA = (bf16_t*)smem;
  bf16_t* sB = sA + 128 * LSTR;
  int tid = threadIdx.x;
  asm volatile("" : "+v"(tid));
  const int lane = tid & 63, wave = tid >> 6;
  const int wm = wave >> 1, wn = wave & 1;
  const int l15 = lane & 15, quad = lane >> 4;
  const int ntm = lat_only ? 256 : 260;
  const int total = ntm * ntn;
  const int lr = tid >> 3, lc = (tid & 7) * 8;
  const bool swz = (gridDim.x & 7) == 0;
  const int xcd = swz ? (blockIdx.x & 7) : 0, lb = swz ? (blockIdx.x >> 3) : blockIdx.x, nlb = swz ? (gridDim.x >> 3) : gridDim.x;
  const int m_lo = swz ? (ntm * xcd) / 8 : 0, m_hi = swz ? (ntm * (xcd + 1)) / 8 : ntm;
  const int nm = m_hi - m_lo;
  const int total_x = nm * ntn;
  (void)total;
  for (int t = lb; t < total_x; t += nlb) {
    const int g = t / (8 * ntn), r = t - g * 8 * ntn;
    const int gsz = min(8, nm - g * 8);
    const int ni = r / gsz, mm = r - ni * gsz;
    const int mi = m_lo + g * 8 + mm;
    const int mt = lat_only ? ((mi >> 7) * 130 + 2 + (mi & 127)) : mi;
    const int row0 = mt * 128, col0 = ni * 128;
    const bf16_t* Ap = A + (size_t)(row0 + lr) * lda + lc;
    const bf16_t* Bp = Wt + (size_t)(col0 + lr) * K + lc;
    f32x4 acc[4][4];
#pragma unroll
    for (int i = 0; i < 4; ++i)
#pragma unroll
      for (int j = 0; j < 4; ++j) acc[i][j] = (f32x4){0.f, 0.f, 0.f, 0.f};
    uint4 ra0, ra1, ra2, ra3, rb0, rb1, rb2, rb3;
    uint4 rc0, rc1, rc2, rc3, rd0, rd1, rd2, rd3;
#define GEMM_LOAD(a0, a1, a2, a3, b0, b1, b2, b3, kk_)        \
  {                                                           \
    a0 = *(const uint4*)(Ap + (kk_));                         \
    a1 = *(const uint4*)(Ap + (size_t)32 * lda + (kk_));      \
    a2 = *(const uint4*)(Ap + (size_t)64 * lda + (kk_));      \
    a3 = *(const uint4*)(Ap + (size_t)96 * lda + (kk_));      \
    b0 = *(const uint4*)(Bp + (kk_));                         \
    b1 = *(const uint4*)(Bp + (size_t)32 * K + (kk_));        \
    b2 = *(const uint4*)(Bp + (size_t)64 * K + (kk_));        \
    b3 = *(const uint4*)(Bp + (size_t)96 * K + (kk_));        \
  }
#define GEMM_STORE(a0, a1, a2, a3, b0, b1, b2, b3, buf_)                   \
  {                                                                        \
    bf16_t* wa = sA + (buf_) * (256 * LSTR);                               \
    bf16_t* wb = wa + 128 * LSTR;                                          \
    *(uint4*)(wa + (lr) * LSTR + lc) = a0;                                 \
    *(uint4*)(wa + (lr + 32) * LSTR + lc) = a1;                            \
    *(uint4*)(wa + (lr + 64) * LSTR + lc) = a2;                            \
    *(uint4*)(wa + (lr + 96) * LSTR + lc) = a3;                            \
    *(uint4*)(wb + (lr) * LSTR + lc) = b0;                                 \
    *(uint4*)(wb + (lr + 32) * LSTR + lc) = b1;                            \
    *(uint4*)(wb + (lr + 64) * LSTR + lc) = b2;                            \
    *(uint4*)(wb + (lr + 96) * LSTR + lc) = b3;                            \
  }
#define GEMM_MMA(buf_, ks_)                                                                                              \
  {                                                                                                                      \
    const bf16_t* ca = sA + (buf_) * (256 * LSTR);                                                                       \
    const bf16_t* cb = ca + 128 * LSTR;                                                                                  \
    bf16x8 af[4], bfr[4];                                                                                                \
    _Pragma("unroll") for (int i = 0; i < 4; ++i)                                                                        \
        af[i] = *(const bf16x8*)(ca + (wm * 64 + i * 16 + l15) * LSTR + (ks_) * 32 + quad * 8);                         \
    _Pragma("unroll") for (int j = 0; j < 4; ++j)                                                                        \
        bfr[j] = *(const bf16x8*)(cb + (wn * 64 + j * 16 + l15) * LSTR + (ks_) * 32 + quad * 8);                        \
    _Pragma("unroll") for (int i = 0; i < 4; ++i) _Pragma("unroll") for (int j = 0; j < 4; ++j)                          \
        acc[i][j] = __builtin_amdgcn_mfma_f32_16x16x32_bf16(bfr[j], af[i], acc[i][j], 0, 0, 0);                         \
  }
    const int nk = K >> 6;
    GEMM_LOAD(ra0, ra1, ra2, ra3, rb0, rb1, rb2, rb3, 0)
    (void)rc0; (void)rc1; (void)rc2; (void)rc3; (void)rd0; (void)rd1; (void)rd2; (void)rd3;
#pragma clang loop unroll(disable)
    for (int kt = 0; kt < nk; ++kt) {
      __syncthreads();
      GEMM_STORE(ra0, ra1, ra2, ra3, rb0, rb1, rb2, rb3, 0)
      __syncthreads();
      if (kt + 1 < nk) GEMM_LOAD(ra0, ra1, ra2, ra3, rb0, rb1, rb2, rb3, (kt + 1) * 64)
      {
        bf16x8 af0[4], bf0[4], af1[4], bf1[4];
        __builtin_amdgcn_s_setprio(1);
#pragma unroll
        for (int i = 0; i < 4; ++i) af0[i] = *(const bf16x8*)(sA + (wm * 64 + i * 16 + l15) * LSTR + quad * 8);
#pragma unroll
        for (int j = 0; j < 4; ++j) bf0[j] = *(const bf16x8*)(sB + (wn * 64 + j * 16 + l15) * LSTR + quad * 8);
#pragma unroll
        for (int i = 0; i < 4; ++i) af1[i] = *(const bf16x8*)(sA + (wm * 64 + i * 16 + l15) * LSTR + 32 + quad * 8);
#pragma unroll
        for (int j = 0; j < 4; ++j) bf1[j] = *(const bf16x8*)(sB + (wn * 64 + j * 16 + l15) * LSTR + 32 + quad * 8);
        __builtin_amdgcn_sched_barrier(0);
#pragma unroll
        for (int i = 0; i < 4; ++i)
#pragma unroll
          for (int j = 0; j < 4; ++j) acc[i][j] = __builtin_amdgcn_mfma_f32_16x16x32_bf16(bf0[j], af0[i], acc[i][j], 0, 0, 0);
#pragma unroll
        for (int i = 0; i < 4; ++i)
#pragma unroll
          for (int j = 0; j < 4; ++j) acc[i][j] = __builtin_amdgcn_mfma_f32_16x16x32_bf16(bf1[j], af1[i], acc[i][j], 0, 0, 0);
        __builtin_amdgcn_s_setprio(0);
      }
    }
    asm volatile("" ::: "memory");
    epi(acc, row0 + wm * 64, col0 + wn * 64, l15, quad);
  }
}

struct EpiIn0 {
  const float *a_qn, *a_kn, *b_qn, *b_kn, *rope;
  bf16_t *AQ, *AK, *AVT, *BQ, *BK, *BVT;
  __device__ __forceinline__ void operator()(const f32x4 (&acc)[4][4], int row0w, int col0w, int l15, int quad) const {
    const int cb = col0w >> 6;
    int kind;
    const float* gain = nullptr;
    bool isq = false;
    if (cb < 8) { kind = 0; gain = a_qn; isq = true; }
    else if (cb < 16) { kind = 1; gain = a_kn; }
    else if (cb < 24) { kind = 2; }
    else if (cb < 32) { kind = 3; gain = b_qn; isq = true; }
    else if (cb < 34) { kind = 4; gain = b_kn; }
    else { kind = 5; }
#pragma unroll
    for (int i = 0; i < 4; ++i) {
      __builtin_amdgcn_sched_barrier(0);
      const int row = row0w + i * 16 + l15;
      const int b = row / TPB, kidx = row - b * TPB;
      float v[4][4];
#pragma unroll
      for (int j = 0; j < 4; ++j)
#pragma unroll
        for (int e = 0; e < 4; ++e) v[j][e] = acc[i][j][e];
      if (gain) {
        float ss = 0.f;
#pragma unroll
        for (int j = 0; j < 4; ++j)
#pragma unroll
          for (int e = 0; e < 4; ++e) ss += v[j][e] * v[j][e];
        ss += __shfl_xor(ss, 16);
        ss += __shfl_xor(ss, 32);
        const float rstd = rsqrtf(ss * (1.0f / 64.0f) + 1e-6f);
#pragma unroll
        for (int j = 0; j < 4; ++j)
#pragma unroll
          for (int e = 0; e < 4; ++e) v[j][e] *= rstd * gain[j * 16 + quad * 4 + e];
        if (kidx >= 256) {
          const int t = kidx - 256, pr = t >> 6, pc = t & 63;
#pragma unroll
          for (int e = 0; e < 4; ++e) {
            const int f = quad * 4 + e;
            const float cr = rope[(pr * 16 + f) * 2], sr = rope[(pr * 16 + f) * 2 + 1];
            const float cc = rope[(pc * 16 + f) * 2], sc = rope[(pc * 16 + f) * 2 + 1];
            float x1 = v[0][e], x2 = v[1][e];
            v[0][e] = x1 * cr - x2 * sr;
            v[1][e] = x2 * cr + x1 * sr;
            x1 = v[2][e]; x2 = v[3][e];
            v[2][e] = x1 * cc - x2 * sc;
            v[3][e] = x2 * cc + x1 * sc;
          }
        }
        if (isq) {
#pragma unroll
          for (int j = 0; j < 4; ++j)
#pragma unroll
            for (int e = 0; e < 4; ++e) v[j][e] *= 0.125f * LOG2E;
        }
      }
      if (kind == 2) {
#pragma unroll
        for (int j = 0; j < 4; ++j)
#pragma unroll
          for (int e = 0; e < 4; ++e) {
            const int c = (cb - 16) * 64 + j * 16 + quad * 4 + e;
            AVT[((size_t)(b * 4 + (c >> 7)) * 128 + (c & 127)) * TPB + kidx] = f2bf(v[j][e]);
          }
      } else if (kind == 5) {
#pragma unroll
        for (int j = 0; j < 4; ++j)
#pragma unroll
          for (int e = 0; e < 4; ++e) {
            const int d = j * 16 + quad * 4 + e;
            BVT[((size_t)(b * 2 + (cb - 34)) * 64 + d) * TPB + kidx] = f2bf(v[j][e]);
          }
      } else {
        bf16_t* dst;
        if (kind == 0) dst = AQ + (size_t)row * 512 + cb * 64;
        else if (kind == 1) dst = AK + (size_t)row * 512 + (cb - 8) * 64;
        else if (kind == 3) dst = BQ + (size_t)row * 512 + (cb - 24) * 64;
        else dst = BK + (size_t)row * 128 + (cb - 32) * 64;
#pragma unroll
        for (int j = 0; j < 4; ++j) {
          uint2 w;
          w.x = pack2(v[j][0], v[j][1]);
          w.y = pack2(v[j][2], v[j][3]);
          *(uint2*)(dst + j * 16 + quad * 4) = w;
        }
      }
    }
  }
};

struct EpiIn1 {
  const float *c_qn, *c_kn;
  bf16_t *CQ, *CK, *CVT, *RAW;
  float* LORA;
  __device__ __forceinline__ void operator()(const f32x4 (&acc)[4][4], int row0w, int col0w, int l15, int quad) const {
    const int cb = col0w >> 6;
#pragma unroll
    for (int i = 0; i < 4; ++i) {
      const int row = row0w + i * 16 + l15;
      const int b = row / TPB, kidx = row - b * TPB;
      float v[4][4];
#pragma unroll
      for (int j = 0; j < 4; ++j)
#pragma unroll
        for (int e = 0; e < 4; ++e) v[j][e] = acc[i][j][e];
      if (cb < 16) {
        const float* gain = cb < 8 ? c_qn : c_kn;
        float ss = 0.f;
#pragma unroll
        for (int j = 0; j < 4; ++j)
#pragma unroll
          for (int e = 0; e < 4; ++e) ss += v[j][e] * v[j][e];
        ss += __shfl_xor(ss, 16);
        ss += __shfl_xor(ss, 32);
        const float rstd = rsqrtf(ss * (1.0f / 64.0f) + 1e-6f) * (cb < 8 ? 0.125f * LOG2E : 1.0f);
        bf16_t* dst = (cb < 8 ? CQ + (size_t)row * 512 + cb * 64 : CK + (size_t)row * 512 + (cb - 8) * 64);
#pragma unroll
        for (int j = 0; j < 4; ++j) {
          const float* gp = gain + j * 16 + quad * 4;
          uint2 w;
          w.x = pack2(v[j][0] * rstd * gp[0], v[j][1] * rstd * gp[1]);
          w.y = pack2(v[j][2] * rstd * gp[2], v[j][3] * rstd * gp[3]);
          *(uint2*)(dst + j * 16 + quad * 4) = w;
        }
      } else if (cb < 24) {
#pragma unroll
        for (int j = 0; j < 4; ++j)
#pragma unroll
          for (int e = 0; e < 4; ++e) {
            const int d = j * 16 + quad * 4 + e;
            CVT[((size_t)(b * 8 + (cb - 16)) * 64 + d) * TPB + kidx] = f2bf(v[j][e]);
          }
      } else if (cb < 48) {
        bf16_t* dst = RAW + (size_t)row * 1536 + (cb - 24) * 64;
#pragma unroll
        for (int j = 0; j < 4; ++j) {
          uint2 w;
          w.x = pack2(v[j][0], v[j][1]);
          w.y = pack2(v[j][2], v[j][3]);
          *(uint2*)(dst + j * 16 + quad * 4) = w;
        }
      } else {
#pragma unroll
        for (int j = 0; j < 4; ++j) {
          const int c = (cb - 48) * 64 + j * 16 + quad * 4;
          if (c < 224) *(float4*)(LORA + (size_t)row * 224 + c) = make_float4(v[j][0], v[j][1], v[j][2], v[j][3]);
        }
      }
    }
  }
};

struct EpiRes {
  const float *lat_src, *ctx_src;
  float *lat_dst, *ctx_dst;
  const float* gate;
  __device__ __forceinline__ void operator()(const f32x4 (&acc)[4][4], int row0w, int col0w, int l15, int quad) const {
#pragma unroll
    for (int i = 0; i < 4; ++i) {
      const int row = row0w + i * 16 + l15;
      const int b = row / TPB, kidx = row - b * TPB;
      const bool isc = kidx < 256;
      const size_t off = isc ? (size_t)(b * 256 + kidx) * DM : (size_t)(b * 16384 + kidx - 256) * DM;
      const float* src = (isc ? ctx_src : lat_src) + off;
      float* dst = (isc ? ctx_dst : lat_dst) + off;
      const float* g = gate + (isc ? 2 : b) * 6144;
#pragma unroll
      for (int j = 0; j < 4; ++j) {
        const int n = col0w + j * 16 + quad * 4;
        const float4 xo = *(const float4*)(src + n);
        const float4 g4 = *(const float4*)(g + n);
        float4 o;
        o.x = xo.x + g4.x * acc[i][j][0];
        o.y = xo.y + g4.y * acc[i][j][1];
        o.z = xo.z + g4.z * acc[i][j][2];
        o.w = xo.w + g4.w * acc[i][j][3];
        *(float4*)(dst + n) = o;
      }
    }
  }
};

struct EpiGU {
  bf16_t* ACT;
  __device__ __forceinline__ void operator()(const f32x4 (&acc)[4][4], int row0w, int col0w, int l15, int quad) const {
    const int chunk = col0w >> 6;
#pragma unroll
    for (int i = 0; i < 4; ++i) {
      const int row = row0w + i * 16 + l15;
#pragma unroll
      for (int j = 0; j < 2; ++j) {
        float r[4];
#pragma unroll
        for (int e = 0; e < 4; ++e) {
          const float g = acc[i][j][e], u = acc[i][j + 2][e];
          r[e] = g * sigmoidf_(g) * u;
        }
        uint2 w;
        w.x = pack2(r[0], r[1]);
        w.y = pack2(r[2], r[3]);
        *(uint2*)(ACT + (size_t)row * DFF + chunk * 32 + j * 16 + quad * 4) = w;
      }
    }
  }
};

template <int NMAP, int NDT, int MODE, bool FIXED>
__device__ __forceinline__ void attn_unit(const bf16_t* __restrict__ Qp, int ldq, const bf16_t* __restrict__ Kp, int ldk,
                                          const bf16_t* __restrict__ Vtp, int seg_lo, int nseg, int qk0,
                                          const float* s_rpb, int na_i, int na_r0, float negM,
                                          f32x4 (&o)[NMAP][NDT], float (&m)[NMAP], float (&l)[NMAP], char* smem) {
  bf16_t* sK = (bf16_t*)smem;
  bf16_t* sVt = sK + NMAP * 64 * LSTR;
  int tid = threadIdx.x;
  asm volatile("" : "+v"(tid));
  const int lane = tid & 63, wave = tid >> 6;
  const int l15 = lane & 15, quad = lane >> 4;
  bf16x8 qf[NMAP][2];
  {
    const bf16_t* qrow = Qp + (size_t)(wave * 16 + l15) * ldq;
#pragma unroll
    for (int c = 0; c < NMAP; ++c)
#pragma unroll
      for (int ks = 0; ks < 2; ++ks) qf[c][ks] = *(const bf16x8*)(qrow + c * 64 + ks * 32 + quad * 8);
  }
#pragma unroll
  for (int c = 0; c < NMAP; ++c) {
    m[c] = -1e30f;
    l[c] = 0.f;
#pragma unroll
    for (int dt = 0; dt < NDT; ++dt) o[c][dt] = (f32x4){0.f, 0.f, 0.f, 0.f};
  }
  const int ntiles = 4 + nseg;
  constexpr int NVL = NDT / 2;
  uint4 rk00, rk01, rk10, rk11, rv0, rv1, rv2, rv3;
  rk10 = rk11 = rv2 = rv3 = make_uint4(0, 0, 0, 0);
  const int lr = tid >> 3, lch = (tid & 7) * 8;
  const uint32_t koff0 = (uint32_t)(lr * ldk + lch) * 2u, koff1 = (uint32_t)((lr + 32) * ldk + lch) * 2u;
  const uint32_t voff0 = (uint32_t)(lr * TPB + lch) * 2u, voff1 = (uint32_t)((lr + 32) * TPB + lch) * 2u,
                 voff2 = (uint32_t)((lr + 64) * TPB + lch) * 2u, voff3 = (uint32_t)((lr + 96) * TPB + lch) * 2u;
#define ATTN_LOAD_K(k0_)                                              \
  {                                                                   \
    const char* kb = (const char*)(Kp + (size_t)(k0_) * ldk);         \
    rk00 = *(const uint4*)(kb + koff0);                               \
    rk01 = *(const uint4*)(kb + koff1);                               \
    if (NMAP > 1) {                                                   \
      rk10 = *(const uint4*)(kb + 128 + koff0);                       \
      rk11 = *(const uint4*)(kb + 128 + koff1);                       \
    }                                                                 \
  }
#define ATTN_LOAD_V(k0_)                                              \
  {                                                                   \
    const char* vb = (const char*)(Vtp + (k0_));                      \
    rv0 = *(const uint4*)(vb + voff0);                                \
    rv1 = *(const uint4*)(vb + voff1);                                \
    if (NVL > 2) {                                                    \
      rv2 = *(const uint4*)(vb + voff2);                              \
      rv3 = *(const uint4*)(vb + voff3);                              \
    }                                                                 \
  }
  ATTN_LOAD_K(0)
  ATTN_LOAD_V(0)
  for (int n = 0; n < ntiles; ++n) {
    const int kidx0 = (MODE == 0) ? n * 64 : (n < 4 ? n * 64 : seg_lo + (n - 4) * 64);
    __syncthreads();
    *(uint4*)(sK + (lr) * LSTR + lch) = rk00;
    *(uint4*)(sK + (lr + 32) * LSTR + lch) = rk01;
    if (NMAP > 1) {
      *(uint4*)(sK + (64 + lr) * LSTR + lch) = rk10;
      *(uint4*)(sK + (64 + lr + 32) * LSTR + lch) = rk11;
    }
    *(uint4*)(sVt + (lr) * LSTR + lch) = rv0;
    *(uint4*)(sVt + (lr + 32) * LSTR + lch) = rv1;
    if (NVL > 2) {
      *(uint4*)(sVt + (lr + 64) * LSTR + lch) = rv2;
      *(uint4*)(sVt + (lr + 96) * LSTR + lch) = rv3;
    }
    __syncthreads();
    const int knext = (MODE == 0) ? (n + 1) * 64 : ((n + 1) < 4 ? (n + 1) * 64 : seg_lo + (n + 1 - 4) * 64);
    if (n + 1 < ntiles) {
      ATTN_LOAD_K(knext)
    }
    bf16x8 pf[NMAP][2];
#pragma unroll
    for (int c = 0; c < NMAP; ++c) {
      f32x4 s[4];
#pragma unroll
      for (int kt = 0; kt < 4; ++kt) {
        const float ini = FIXED ? negM : 0.f;
        s[kt] = (f32x4){ini, ini, ini, ini};
        const int krow = 32 * (kt >> 1) + (l15 >> 2) * 8 + (kt & 1) * 4 + (l15 & 3);
#pragma unroll
        for (int ks = 0; ks < 2; ++ks) {
          const bf16x8 kf = *(const bf16x8*)(sK + (c * 64 + krow) * LSTR + ks * 32 + quad * 8);
          s[kt] = __builtin_amdgcn_mfma_f32_16x16x32_bf16(kf, qf[c][ks], s[kt], 0, 0, 0);
        }
      }
      if (MODE == 1 && n >= 4) {
        const int kp0 = kidx0 - 256, qp = qk0 - 256 + wave * 16 + l15;
#pragma unroll
        for (int kt = 0; kt < 4; ++kt)
#pragma unroll
          for (int e = 0; e < 4; ++e) {
            const int d = qp - (kp0 + 32 * (kt >> 1) + quad * 8 + (kt & 1) * 4 + e);
            if (d > 128 || d < -128) s[kt][e] = -1e30f;
          }
      }
      if (MODE == 2 && n >= 4) {
        const int ri = na_r0 + (n - 4) - na_i + 7;
        const int qc = wave * 16 + l15;
        const int cs = min(max(qc - 8, 0), 48);
#pragma unroll
        for (int kt = 0; kt < 4; ++kt)
#pragma unroll
          for (int e = 0; e < 4; ++e) {
            const int kc = 32 * (kt >> 1) + quad * 8 + (kt & 1) * 4 + e;
            if (kc >= cs && kc < cs + 16) s[kt][e] += s_rpb[ri * 31 + kc - qc + 15];
            else s[kt][e] = -1e30f;
          }
      }
      if (FIXED) {
        float ls = 0.f;
#pragma unroll
        for (int kt = 0; kt < 4; ++kt)
#pragma unroll
          for (int e = 0; e < 4; ++e) {
            s[kt][e] = fexp2(s[kt][e]);
            ls += s[kt][e];
          }
        l[c] += ls;
      } else {
        float mx = s[0][0];
#pragma unroll
        for (int kt = 0; kt < 4; ++kt)
#pragma unroll
          for (int e = 0; e < 4; ++e) mx = fmaxf(mx, s[kt][e]);
        mx = fmaxf(mx, __shfl_xor(mx, 16));
        mx = fmaxf(mx, __shfl_xor(mx, 32));
        const float mnew = fmaxf(m[c], mx);
        const float alpha = fexp2(m[c] - mnew);
        m[c] = mnew;
        float ls = 0.f;
#pragma unroll
        for (int kt = 0; kt < 4; ++kt)
#pragma unroll
          for (int e = 0; e < 4; ++e) {
            s[kt][e] = fexp2(s[kt][e] - mnew);
            ls += s[kt][e];
          }
        l[c] = l[c] * alpha + ls;
        if (__ballot(alpha != 1.0f) != 0ull) {
#pragma unroll
          for (int dt = 0; dt < NDT; ++dt) o[c][dt] *= alpha;
        }
      }
      __builtin_amdgcn_sched_barrier(0);
#pragma unroll
      for (int ks2 = 0; ks2 < 2; ++ks2) {
        union { uint32_t u[4]; bf16x8 v; } pk;
        pk.u[0] = pack2(s[2 * ks2][0], s[2 * ks2][1]);
        pk.u[1] = pack2(s[2 * ks2][2], s[2 * ks2][3]);
        pk.u[2] = pack2(s[2 * ks2 + 1][0], s[2 * ks2 + 1][1]);
        pk.u[3] = pack2(s[2 * ks2 + 1][2], s[2 * ks2 + 1][3]);
        pf[c][ks2] = pk.v;
      }
    }
    if (n + 1 < ntiles) {
      ATTN_LOAD_V(knext)
    }
#pragma unroll
    for (int ks2 = 0; ks2 < 2; ++ks2) {
      __builtin_amdgcn_sched_barrier(0);
#pragma unroll
      for (int dt = 0; dt < NDT; ++dt) {
        const bf16x8 vf = *(const bf16x8*)(sVt + (dt * 16 + l15) * LSTR + 32 * ks2 + quad * 8);
#pragma unroll
        for (int c = 0; c < NMAP; ++c) o[c][dt] = __builtin_amdgcn_mfma_f32_16x16x32_bf16(vf, pf[c][ks2], o[c][dt], 0, 0, 0);
      }
    }
  }
#pragma unroll
  for (int c = 0; c < NMAP; ++c) {
    l[c] += __shfl_xor(l[c], 16);
    l[c] += __shfl_xor(l[c], 32);
  }
}

__device__ __forceinline__ void attn_diff32(const bf16_t* __restrict__ Qp, const bf16_t* __restrict__ Kp,
                                            const bf16_t* __restrict__ Vtp, int ntiles, float negM,
                                            f32x4 (&o)[2][8], float (&l)[2], char* smem) {
  bf16_t* sK = (bf16_t*)smem;
  bf16_t* sVt = sK + 2 * 64 * LSTR;
  int tid = threadIdx.x;
  asm volatile("" : "+v"(tid));
  const int lane = tid & 63, wave = tid >> 6;
  const int l15 = lane & 15, quad = lane >> 4;
  const int cmap = wave >> 1, qg = wave & 1;
  bf16x8 qf[2][2];
#pragma unroll
  for (int qt = 0; qt < 2; ++qt) {
    const bf16_t* qrow = Qp + (size_t)(qg * 32 + qt * 16 + l15) * 512 + cmap * 64;
#pragma unroll
    for (int ks = 0; ks < 2; ++ks) qf[qt][ks] = *(const bf16x8*)(qrow + ks * 32 + quad * 8);
  }
#pragma unroll
  for (int qt = 0; qt < 2; ++qt) {
    l[qt] = 0.f;
#pragma unroll
    for (int dt = 0; dt < 8; ++dt) o[qt][dt] = (f32x4){0.f, 0.f, 0.f, 0.f};
  }
  uint4 rk00, rk01, rk10, rk11, rv0, rv1, rv2, rv3;
  const int lr = tid >> 3, lch = (tid & 7) * 8;
  const uint32_t koff0 = (uint32_t)(lr * 512 + lch) * 2u, koff1 = (uint32_t)((lr + 32) * 512 + lch) * 2u;
  const uint32_t voff0 = (uint32_t)(lr * TPB + lch) * 2u, voff1 = (uint32_t)((lr + 32) * TPB + lch) * 2u,
                 voff2 = (uint32_t)((lr + 64) * TPB + lch) * 2u, voff3 = (uint32_t)((lr + 96) * TPB + lch) * 2u;
#define AD_LOAD_K(k0_)                                                \
  {                                                                   \
    const char* kb = (const char*)(Kp + (size_t)(k0_) * 512);         \
    rk00 = *(const uint4*)(kb + koff0);                               \
    rk01 = *(const uint4*)(kb + koff1);                               \
    rk10 = *(const uint4*)(kb + 128 + koff0);                         \
    rk11 = *(const uint4*)(kb + 128 + koff1);                         \
  }
#define AD_LOAD_V(k0_)                                                \
  {                                                                   \
    const char* vb = (const char*)(Vtp + (k0_));                      \
    rv0 = *(const uint4*)(vb + voff0);                                \
    rv1 = *(const uint4*)(vb + voff1);                                \
    rv2 = *(const uint4*)(vb + voff2);                                \
    rv3 = *(const uint4*)(vb + voff3);                                \
  }
  AD_LOAD_K(0)
  AD_LOAD_V(0)
  const bf16_t* sKc = sK + cmap * 64 * LSTR;
  for (int n = 0; n < ntiles; ++n) {
    __syncthreads();
    *(uint4*)(sK + (lr) * LSTR + lch) = rk00;
    *(uint4*)(sK + (lr + 32) * LSTR + lch) = rk01;
    *(uint4*)(sK + (64 + lr) * LSTR + lch) = rk10;
    *(uint4*)(sK + (64 + lr + 32) * LSTR + lch) = rk11;
    *(uint4*)(sVt + (lr) * LSTR + lch) = rv0;
    *(uint4*)(sVt + (lr + 32) * LSTR + lch) = rv1;
    *(uint4*)(sVt + (lr + 64) * LSTR + lch) = rv2;
    *(uint4*)(sVt + (lr + 96) * LSTR + lch) = rv3;
    __syncthreads();
    const int knext = (n + 1) * 64;
    if (n + 1 < ntiles) { AD_LOAD_K(knext) }
    f32x4 s[2][4];
    __builtin_amdgcn_s_setprio(1);
#pragma unroll
    for (int kt = 0; kt < 4; ++kt) {
      s[0][kt] = (f32x4){negM, negM, negM, negM};
      s[1][kt] = (f32x4){negM, negM, negM, negM};
      const int krow = 32 * (kt >> 1) + (l15 >> 2) * 8 + (kt & 1) * 4 + (l15 & 3);
#pragma unroll
      for (int ks = 0; ks < 2; ++ks) {
        const bf16x8 kf = *(const bf16x8*)(sKc + krow * LSTR + ks * 32 + quad * 8);
        s[0][kt] = __builtin_amdgcn_mfma_f32_16x16x32_bf16(kf, qf[0][ks], s[0][kt], 0, 0, 0);
        s[1][kt] = __builtin_amdgcn_mfma_f32_16x16x32_bf16(kf, qf[1][ks], s[1][kt], 0, 0, 0);
      }
    }
    __builtin_amdgcn_s_setprio(0);
    bf16x8 pf[2][2];
#pragma unroll
    for (int qt = 0; qt < 2; ++qt) {
      float ls = 0.f;
#pragma unroll
      for (int kt = 0; kt < 4; ++kt)
#pragma unroll
        for (int e = 0; e < 4; ++e) {
          s[qt][kt][e] = fexp2(s[qt][kt][e]);
          ls += s[qt][kt][e];
        }
      l[qt] += ls;
#pragma unroll
      for (int ks2 = 0; ks2 < 2; ++ks2) {
        union { uint32_t u[4]; bf16x8 v; } pk;
        pk.u[0] = pack2(s[qt][2 * ks2][0], s[qt][2 * ks2][1]);
        pk.u[1] = pack2(s[qt][2 * ks2][2], s[qt][2 * ks2][3]);
        pk.u[2] = pack2(s[qt][2 * ks2 + 1][0], s[qt][2 * ks2 + 1][1]);
        pk.u[3] = pack2(s[qt][2 * ks2 + 1][2], s[qt][2 * ks2 + 1][3]);
        pf[qt][ks2] = pk.v;
      }
    }
    if (n + 1 < ntiles) { AD_LOAD_V(knext) }
    __builtin_amdgcn_s_setprio(1);
#pragma unroll
    for (int ks2 = 0; ks2 < 2; ++ks2)
#pragma unroll
      for (int dt = 0; dt < 8; ++dt) {
        const bf16x8 vf = *(const bf16x8*)(sVt + (dt * 16 + l15) * LSTR + 32 * ks2 + quad * 8);
        o[0][dt] = __builtin_amdgcn_mfma_f32_16x16x32_bf16(vf, pf[0][ks2], o[0][dt], 0, 0, 0);
        o[1][dt] = __builtin_amdgcn_mfma_f32_16x16x32_bf16(vf, pf[1][ks2], o[1][dt], 0, 0, 0);
      }
    __builtin_amdgcn_s_setprio(0);
  }
#pragma unroll
  for (int qt = 0; qt < 2; ++qt) {
    l[qt] += __shfl_xor(l[qt], 16);
    l[qt] += __shfl_xor(l[qt], 32);
  }
}

__device__ __forceinline__ void phase_attn0(const Params& P, char* smem) {
  char* ws = P.ws;
  const bf16_t* AQ = (const bf16_t*)(ws + OFF_AQ);
  const bf16_t* AK = (const bf16_t*)(ws + OFF_AK);
  const bf16_t* AVT = (const bf16_t*)(ws + OFF_AVT);
  const bf16_t* BQ = (const bf16_t*)(ws + OFF_BQ);
  const bf16_t* BK = (const bf16_t*)(ws + OFF_BK);
  const bf16_t* BVT = (const bf16_t*)(ws + OFF_BVT);
  bf16_t* Acat = (bf16_t*)(ws + OFF_A);
  const float lam = ((const float*)(ws + OFF_LAM))[0];
  const float negM = -((const float*)(ws + OFF_LAM))[1];
  const bool fixed_ok = ((const float*)(ws + OFF_LAM))[1] < 60.0f;
  const float lambda_init = 0.2f;
  const int lane = threadIdx.x & 63, wave = threadIdx.x >> 6, l15 = lane & 15, quad = lane >> 4;
  for (int u = blockIdx.x; u < 2080; u += gridDim.x) {
    int b, head, qb;
    if (u < 2048) {
      const int bh = u & 7;
      b = bh >> 2; head = bh & 3; qb = 4 + (u >> 3);
    }
    else { const int cu = u - 2048; b = cu >> 4; head = (cu >> 2) & 3; qb = cu & 3; }
    const int qk0 = qb * 64;
    const int nseg = qb >= 4 ? 256 : 0;
    f32x4 o[2][8];
    float m[2], l[2];
    if (fixed_ok) {
      f32x4 o2[2][8];
      float l2[2];
      attn_diff32(AQ + (size_t)(b * TPB + qk0) * 512 + head * 128, AK + (size_t)(b * TPB) * 512 + head * 128,
                  AVT + (size_t)(b * 4 + head) * 128 * TPB, 4 + nseg, negM, o2, l2, smem);
      float* xch = (float*)smem;
      const int cmap = wave >> 1, qg = wave & 1;
      __syncthreads();
      if (cmap == 1) {
#pragma unroll
        for (int qt = 0; qt < 2; ++qt) {
          const float i1 = lam / l2[qt];
#pragma unroll
          for (int dt = 0; dt < 8; ++dt)
            *(f32x4*)(xch + (size_t)((qg * 32 + qt * 16 + l15) * 128 + dt * 16 + quad * 4)) = o2[qt][dt] * i1;
        }
      }
      __syncthreads();
      if (cmap == 0) {
#pragma unroll
        for (int qt = 0; qt < 2; ++qt) {
          const float i0 = 1.0f / l2[qt];
          float ss = 0.f;
#pragma unroll
          for (int dt = 0; dt < 8; ++dt) {
            const f32x4 other = *(const f32x4*)(xch + (size_t)((qg * 32 + qt * 16 + l15) * 128 + dt * 16 + quad * 4));
            o2[qt][dt] = o2[qt][dt] * i0 - other;
#pragma unroll
            for (int e = 0; e < 4; ++e) ss += o2[qt][dt][e] * o2[qt][dt][e];
          }
          ss += __shfl_xor(ss, 16);
          ss += __shfl_xor(ss, 32);
          const float rstd = rsqrtf(ss * (1.0f / 128.0f) + 1e-6f) * (1.0f - lambda_init);
          const int row = b * TPB + qk0 + qg * 32 + qt * 16 + l15;
          bf16_t* dst = Acat + (size_t)row * DM + head * 128;
#pragma unroll
          for (int dt = 0; dt < 8; ++dt) {
            const float* sg = P.a_subln + dt * 16 + quad * 4;
            uint2 w;
            w.x = pack2(o2[qt][dt][0] * rstd * sg[0], o2[qt][dt][1] * rstd * sg[1]);
            w.y = pack2(o2[qt][dt][2] * rstd * sg[2], o2[qt][dt][3] * rstd * sg[3]);
            *(uint2*)(dst + dt * 16 + quad * 4) = w;
          }
        }
      }
      continue;
    }
    {
      attn_unit<2, 8, 0, false>(AQ + (size_t)(b * TPB + qk0) * 512 + head * 128, 512, AK + (size_t)(b * TPB) * 512 + head * 128, 512,
                                AVT + (size_t)(b * 4 + head) * 128 * TPB, 256, nseg, qk0, nullptr, 0, 0, 0.f, o, m, l, smem);
    }

    const float i0 = 1.0f / l[0], i1 = lam / l[1];
    float ss = 0.f;
#pragma unroll
    for (int dt = 0; dt < 8; ++dt)
#pragma unroll
      for (int e = 0; e < 4; ++e) {
        const float v = o[0][dt][e] * i0 - o[1][dt][e] * i1;
        o[0][dt][e] = v;
        ss += v * v;
      }
    ss += __shfl_xor(ss, 16);
    ss += __shfl_xor(ss, 32);
    const float rstd = rsqrtf(ss * (1.0f / 128.0f) + 1e-6f) * (1.0f - lambda_init);
    const int row = b * TPB + qk0 + wave * 16 + l15;
    bf16_t* dst = Acat + (size_t)row * DM + head * 128;
#pragma unroll
    for (int dt = 0; dt < 8; ++dt) {
      const float* sg = P.a_subln + dt * 16 + quad * 4;
      uint2 w;
      w.x = pack2(o[0][dt][0] * rstd * sg[0], o[0][dt][1] * rstd * sg[1]);
      w.y = pack2(o[0][dt][2] * rstd * sg[2], o[0][dt][3] * rstd * sg[3]);
      *(uint2*)(dst + dt * 16 + quad * 4) = w;
    }
  }
  for (int u = blockIdx.x; u < 4160; u += gridDim.x) {
    const int b = u / 2080, r = u - b * 2080, qh = r / 260, qb = r - qh * 260;
    const int g = qh >> 2;
    const int qk0 = qb * 64;
    int seg_lo = 256, nseg = 0;
    if (qb >= 4) {
      int lo = qk0 - 128, hi = qk0 + 128;
      if (lo < 256) lo = 256;
      if (hi > TPB - 64) hi = TPB - 64;
      seg_lo = lo;
      nseg = (hi - lo) / 64 + 1;
    }
    f32x4 o[1][4];
    float m[1], l[1];
    attn_unit<1, 4, 1, false>(BQ + (size_t)(b * TPB + qk0) * 512 + qh * 64, 512, BK + (size_t)(b * TPB) * 128 + g * 64, 128,
                              BVT + (size_t)(b * 2 + g) * 64 * TPB, seg_lo, nseg, qk0, nullptr, 0, 0, 0.f, o, m, l, smem);
    const float lt = l[0] + fexp2(P.b_sink[qh] * LOG2E - m[0]);
    const float inv = 1.0f / lt;
    const int row = b * TPB + qk0 + wave * 16 + l15;
    bf16_t* dst = Acat + (size_t)row * DM + 512 + qh * 64;
#pragma unroll
    for (int dt = 0; dt < 4; ++dt) {
      uint2 w;
      w.x = pack2(o[0][dt][0] * inv, o[0][dt][1] * inv);
      w.y = pack2(o[0][dt][2] * inv, o[0][dt][3] * inv);
      *(uint2*)(dst + dt * 16 + quad * 4) = w;
    }
  }
}

__device__ __forceinline__ void phase_na(const Params& P, char* smem) {
  char* ws = P.ws;
  const bf16_t* CQ = (const bf16_t*)(ws + OFF_CQ);
  const bf16_t* CK = (const bf16_t*)(ws + OFF_CK);
  const bf16_t* CVT = (const bf16_t*)(ws + OFF_CVT);
  bf16_t* Acat = (bf16_t*)(ws + OFF_A);
  float* s_rpb = (float*)(smem + 40960);
  const int lane = threadIdx.x & 63, wave = threadIdx.x >> 6, l15 = lane & 15, quad = lane >> 4;
  for (int u = blockIdx.x; u < 4096; u += gridDim.x) {
    const int b = u >> 11, h = (u >> 8) & 7, gi = u & 255;
    const int r0 = min(max(gi - 4, 0), 248);
    __syncthreads();
    for (int e = threadIdx.x; e < 465; e += 256) s_rpb[e] = P.c_rpb[h * 465 + e] * LOG2E;
    __syncthreads();
    const int qk0 = 256 + gi * 64;
    f32x4 o[1][4];
    float m[1], l[1];
    attn_unit<1, 4, 2, false>(CQ + (size_t)(b * TPB + qk0) * 512 + h * 64, 512, CK + (size_t)(b * TPB) * 512 + h * 64, 512,
                              CVT + (size_t)(b * 8 + h) * 64 * TPB, 256 + r0 * 64, 8, qk0, s_rpb, gi, r0, 0.f, o, m, l, smem);
    const float inv = 1.0f / l[0];
    const int row = b * TPB + qk0 + wave * 16 + l15;
    bf16_t* dst = Acat + (size_t)row * DM + h * 64;
#pragma unroll
    for (int dt = 0; dt < 4; ++dt) {
      uint2 w;
      w.x = pack2(o[0][dt][0] * inv, o[0][dt][1] * inv);
      w.y = pack2(o[0][dt][2] * inv, o[0][dt][3] * inv);
      *(uint2*)(dst + dt * 16 + quad * 4) = w;
    }
  }
}

__device__ __forceinline__ void phase_norm(const float* lat_src, const float* ctx_src, const float* gain, const float* modl,
                                           int sh_off, int sc_off, bf16_t* A, bool lat_only) {
  const int lane = threadIdx.x & 63, wave = threadIdx.x >> 6;
  const int total = lat_only ? 32768 : MROWS;
  for (int idx0 = (blockIdx.x * 4 + wave) * 2; idx0 < total; idx0 += gridDim.x * 8) {
    float4 xv[2][4];
    const float* md[2];
    int rowi[2];
#pragma unroll
    for (int u = 0; u < 2; ++u) {
      const int idx = idx0 + u;
      const int row = lat_only ? ((idx >> 14) * TPB + 256 + (idx & 16383)) : idx;
      const int b = row / TPB, kidx = row - b * TPB;
      const bool isc = kidx < 256;
      const float* src = isc ? ctx_src + (size_t)(b * 256 + kidx) * DM : lat_src + (size_t)(b * 16384 + kidx - 256) * DM;
      md[u] = modl + (isc ? 2 : b) * 6144;
      rowi[u] = row;
#pragma unroll
      for (int i = 0; i < 4; ++i) xv[u][i] = *(const float4*)(src + i * 256 + lane * 4);
    }
#pragma unroll
    for (int u = 0; u < 2; ++u) {
      float ss = 0.f;
#pragma unroll
      for (int i = 0; i < 4; ++i) ss += xv[u][i].x * xv[u][i].x + xv[u][i].y * xv[u][i].y + xv[u][i].z * xv[u][i].z + xv[u][i].w * xv[u][i].w;
      ss = wave_sum(ss);
      const float rstd = rsqrtf(ss * (1.0f / 1024.0f) + 1e-6f);
#pragma unroll
      for (int i = 0; i < 4; ++i) {
        const int c = i * 256 + lane * 4;
        const float4 g = *(const float4*)(gain + c);
        const float4 sh = *(const float4*)(md[u] + sh_off + c);
        const float4 sc = *(const float4*)(md[u] + sc_off + c);
        uint2 w;
        w.x = pack2(xv[u][i].x * rstd * g.x * (1.f + sc.x) + sh.x, xv[u][i].y * rstd * g.y * (1.f + sc.y) + sh.y);
        w.y = pack2(xv[u][i].z * rstd * g.z * (1.f + sc.z) + sh.z, xv[u][i].w * rstd * g.w * (1.f + sc.w) + sh.w);
        *(uint2*)(A + (size_t)rowi[u] * DM + c) = w;
      }
    }
  }
}

__device__ __forceinline__ void conv_tile(const float* __restrict__ W, int K, int N, int Npad, bf16_t* __restrict__ dst, int mode,
                          int kt, int nt, char* smem) {
  float* T = (float*)smem;
  const int tid = threadIdx.x;
  const int k0 = kt * 64, n0 = nt * 64;
  __syncthreads();
  {
    const int r = tid >> 4, c4 = (tid & 15) * 4;
#pragma unroll
    for (int i = 0; i < 4; ++i) {
      const int k = r + 16 * i, n = n0 + c4;
      float4 v = make_float4(0.f, 0.f, 0.f, 0.f);
      if (n < N) v = *(const float4*)(W + (size_t)(k0 + k) * N + n);
      T[k * 65 + c4 + 0] = v.x;
      T[k * 65 + c4 + 1] = v.y;
      T[k * 65 + c4 + 2] = v.z;
      T[k * 65 + c4 + 3] = v.w;
    }
  }
  __syncthreads();
  {
    const int n = tid >> 2, ks = (tid & 3) * 16;
    const int gn = n0 + n;
    if (gn < Npad) {
      const int drow = mode == 0 ? gn : ((gn >> 5) * 64 + (gn & 31) + (mode == 2 ? 32 : 0));
      uint32_t w[8];
#pragma unroll
      for (int q = 0; q < 8; ++q) w[q] = pack2(T[(ks + 2 * q) * 65 + n], T[(ks + 2 * q + 1) * 65 + n]);
      uint4* d = (uint4*)(dst + (size_t)drow * K + k0 + ks);
      d[0] = make_uint4(w[0], w[1], w[2], w[3]);
      d[1] = make_uint4(w[4], w[5], w[6], w[7]);
    }
  }
}

__device__ __forceinline__ void phase_conv(const Params& P, int layer, char* smem, int part, int rank, int nrank) {
  char* ws = P.ws;
  const float* w_in = layer == 0 ? P.ab_w_in : P.cd_w_in;
  const int n_in = layer == 0 ? 2304 : 3296;
  const int np_in = layer == 0 ? 2304 : 3328;
  const int nt_in = np_in / 64;
  const float* w_out = layer == 0 ? P.ab_w_out : P.cd_w_out;
  const int t_in = 16 * nt_in;
  const int t_lo = part == 2 ? t_in : 0;
  const int total = part == 1 ? t_in : t_in + 256 + 3 * 704;
  for (int t = t_lo + rank; t < total; t += nrank) {
    if (t < t_in) {
      conv_tile(w_in, 1024, n_in, np_in, (bf16_t*)(ws + OFF_WIN), 0, t / nt_in, t % nt_in, smem);
    } else if (t < t_in + 256) {
      const int q = t - t_in;
      conv_tile(w_out, 1024, 1024, 1024, (bf16_t*)(ws + OFF_WOUT), 0, q >> 4, q & 15, smem);
    } else if (t < t_in + 256 + 704) {
      const int q = t - t_in - 256;
      conv_tile(P.w_gate + (size_t)layer * 1024 * DFF, 1024, DFF, DFF, (bf16_t*)(ws + OFF_WGU), 1, q / 44, q % 44, smem);
    } else if (t < t_in + 256 + 1408) {
      const int q = t - t_in - 256 - 704;
      conv_tile(P.w_up + (size_t)layer * 1024 * DFF, 1024, DFF, DFF, (bf16_t*)(ws + OFF_WGU), 2, q / 44, q % 44, smem);
    } else {
      const int q = t - t_in - 256 - 1408;
      conv_tile(P.w_down + (size_t)layer * DFF * 1024, DFF, 1024, 1024, (bf16_t*)(ws + OFF_WDN), 0, q >> 4, q & 15, smem);
    }
  }
}

__device__ __forceinline__ void phase_adaln(const Params& P, char* smem) {
  float* sc = (float*)smem;
  float* red = sc + 3 * 1024;
  float* mod = (float*)(P.ws + OFF_MOD);
  const int tid = threadIdx.x;
  for (int it = blockIdx.x; it < 192; it += gridDim.x) {
    const int layer = it / 96, n0 = (it % 96) * 64;
    __syncthreads();
    for (int e = tid; e < 3072; e += 256) {
      const int i = e >> 10, k = e & 1023;
      const float v = i < 2 ? P.c[i * 1024 + k] : P.c_ctx[k];
      sc[e] = v / (1.0f + __expf(-v));
    }
    __syncthreads();
    const int kg = tid >> 6, col = tid & 63;
    const float* w = P.ada_w + (size_t)layer * 1024 * 6144 + n0 + col;
    float a0 = 0.f, a1 = 0.f, a2 = 0.f;
#pragma unroll 8
    for (int k = kg * 256; k < kg * 256 + 256; ++k) {
      const float wv = w[(size_t)k * 6144];
      a0 += sc[k] * wv;
      a1 += sc[1024 + k] * wv;
      a2 += sc[2048 + k] * wv;
    }
    red[(kg * 64 + col) * 3 + 0] = a0;
    red[(kg * 64 + col) * 3 + 1] = a1;
    red[(kg * 64 + col) * 3 + 2] = a2;
    __syncthreads();
    if (tid < 192) {
      const int i = tid >> 6, cl = tid & 63;
      float s = P.ada_b[layer * 6144 + n0 + cl];
#pragma unroll
      for (int g = 0; g < 4; ++g) s += red[(g * 64 + cl) * 3 + i];
      mod[(layer * 3 + i) * 6144 + n0 + cl] = s;
    }
  }
  if (blockIdx.x == gridDim.x - 1) {
    float* rope = (float*)(P.ws + OFF_ROPE);
    for (int e = tid; e < 4096; e += 256) {
      const int p = e >> 4, f = e & 15;
      const float freq = powf(10000.0f, -(float)(2 * f) / 32.0f);
      const float ang = (float)p * freq;
      rope[e * 2] = cosf(ang);
      rope[e * 2 + 1] = sinf(ang);
    }
    if (tid < 64) {
      float p0 = P.a_lambda[tid] * P.a_lambda[64 + tid];
      float p1 = P.a_lambda[128 + tid] * P.a_lambda[192 + tid];
      p0 = wave_sum(p0);
      p1 = wave_sum(p1);
      float gq = fabsf(P.a_qn[tid]), gk = fabsf(P.a_kn[tid]);
#pragma unroll
      for (int o = 32; o >= 1; o >>= 1) {
        gq = fmaxf(gq, __shfl_xor(gq, o));
        gk = fmaxf(gk, __shfl_xor(gk, o));
      }
      if (tid == 0) {
        ((float*)(P.ws + OFF_LAM))[0] = expf(p0) - expf(p1) + 0.2f;
        ((float*)(P.ws + OFF_LAM))[1] = 8.0f * gq * gk * LOG2E * 1.001f + 0.01f;
      }
    }
  }
}

__device__ __forceinline__ float dppf8(float x, const int sel) {
  const int xi = __float_as_int(x);
  int r;
  if (sel == 0) r = __builtin_amdgcn_update_dpp(0, xi, 0xB1, 0xF, 0xF, true);
  else if (sel == 1) r = __builtin_amdgcn_update_dpp(0, xi, 0x4E, 0xF, 0xF, true);
  else r = __builtin_amdgcn_update_dpp(0, xi, 0x141, 0xF, 0xF, true);
  return __int_as_float(r);
}
__device__ __forceinline__ void phase_lora_conv(const Params& P) {
  bf16_t* WL = (bf16_t*)(P.ws + OFF_WL);
  if (threadIdx.x < 224) {
    const int cl = threadIdx.x / 28, kg = threadIdx.x - cl * 28;
    for (int cb = blockIdx.x; cb < 64; cb += gridDim.x) {
      const int c = cb * 8 + cl;
      float v[8];
#pragma unroll
      for (int q = 0; q < 8; ++q) {
        const int kk = kg * 8 + q;
        if (kk < 64) v[q] = P.d_w2[(size_t)kk * 512 + c];
        else if (kk < 128) v[q] = P.d_a2[(size_t)(kk - 64) * 512 + c];
        else v[q] = P.d_g2[(size_t)(kk - 128) * 512 + c];
      }
      *(uint4*)(WL + (size_t)c * 224 + kg * 8) = make_uint4(pack2(v[0], v[1]), pack2(v[2], v[3]), pack2(v[4], v[5]), pack2(v[6], v[7]));
    }
  }
}

#define PREP_T 16
#define SLS 232
__device__ __forceinline__ void phase_prep(const Params& P, char* smem) {
  char* ws = P.ws;
  bf16_t* sL = (bf16_t*)smem;
  const bf16_t* RAW = (const bf16_t*)(ws + OFF_RAW);
  const float* LORA = (const float*)(ws + OFF_LORA);
  const bf16_t* WL = (const bf16_t*)(ws + OFF_WL);
  bf16_t* XR = (bf16_t*)(ws + OFF_XR);
  bf16_t* XK = (bf16_t*)(ws + OFF_XK);
  bf16_t* XV = (bf16_t*)(ws + OFF_XV);
  bf16_t* KK = (bf16_t*)(ws + OFF_KK);
  bf16_t* DP = (bf16_t*)(ws + OFF_DP);
  bf16_t* AZ = (bf16_t*)(ws + OFF_AZ);
  bf16_t* Acat = (bf16_t*)(ws + OFF_A);
  const float* mu = P.d_mu;
  const int tid = threadIdx.x, lane = tid & 63, wave = tid >> 6, l15 = lane & 15, quad = lane >> 4;
  for (int tt = blockIdx.x; tt < MROWS / PREP_T; tt += gridDim.x) {
    const int row0 = tt * PREP_T;
    const int b = row0 / TPB, k0 = row0 - b * TPB;
    __syncthreads();
    for (int e = tid; e < PREP_T * 8; e += 256) sL[(e >> 3) * SLS + 224 + (e & 7)] = 0;
#pragma unroll 7
    for (int e = tid; e < PREP_T * 224; e += 256) {
      const int tok = e / 224, j = e - tok * 224;
      const int kidx = k0 + tok, row = row0 + tok;
      const bool hp = (kidx != 0 && kidx != 256), hn = (kidx != 255 && kidx != TPB - 1);
      const float x = LORA[(size_t)row * 224 + j];
      const float xp = hp ? LORA[(size_t)(row - 1) * 224 + j] : 0.f;
      const float xn = hn ? LORA[(size_t)(row + 1) * 224 + j] : 0.f;
      const float xs = x + mu[1536 + j] * (0.5f * (xp + xn) - x);
      sL[tok * SLS + j] = f2bf(j < 64 ? (1.0f - 2.0f * __builtin_amdgcn_rcpf(__expf(2.0f * xs) + 1.0f)) : (j < 128 ? xs : sigmoidf_(xs)));
    }
    __syncthreads();
    for (int nt = 0; nt < 8; ++nt) {
      const int n0 = wave * 128 + nt * 16;
      bf16x8 wf[7];
#pragma unroll
      for (int kb = 0; kb < 7; ++kb) wf[kb] = *(const bf16x8*)(WL + (size_t)(n0 + l15) * 224 + kb * 32 + quad * 8);
      const int c4 = n0 + quad * 4;
      const float4 w00 = *(const float4*)(P.d_w0 + c4), w01 = *(const float4*)(P.d_w0 + 512 + c4);
      const float4 a00 = *(const float4*)(P.d_a0 + c4), a01 = *(const float4*)(P.d_a0 + 512 + c4);
#pragma unroll
      for (int mt = 0; mt < PREP_T / 16; ++mt) {
        bf16x8 af[7];
#pragma unroll
        for (int kb = 0; kb < 7; ++kb) af[kb] = *(const bf16x8*)(sL + (mt * 16 + l15) * SLS + kb * 32 + quad * 8);
        const f32x4 zero = (f32x4){0.f, 0.f, 0.f, 0.f};
        f32x4 aw0 = __builtin_amdgcn_mfma_f32_16x16x32_bf16(wf[0], af[0], zero, 0, 0, 0);
        f32x4 aw1 = __builtin_amdgcn_mfma_f32_16x16x32_bf16(wf[1], af[1], zero, 0, 0, 0);
        f32x4 aa0 = __builtin_amdgcn_mfma_f32_16x16x32_bf16(wf[2], af[2], zero, 0, 0, 0);
        f32x4 aa1 = __builtin_amdgcn_mfma_f32_16x16x32_bf16(wf[3], af[3], zero, 0, 0, 0);
        f32x4 ag = __builtin_amdgcn_mfma_f32_16x16x32_bf16(wf[4], af[4], zero, 0, 0, 0);
        ag = __builtin_amdgcn_mfma_f32_16x16x32_bf16(wf[5], af[5], ag, 0, 0, 0);
        ag = __builtin_amdgcn_mfma_f32_16x16x32_bf16(wf[6], af[6], ag, 0, 0, 0);
        const size_t row = (size_t)(row0 + mt * 16 + l15);
        float dp0[4], dp1[4], az0[4], az1[4];
#pragma unroll
        for (int e = 0; e < 4; ++e) {
          const float wb0 = e == 0 ? w00.x : (e == 1 ? w00.y : (e == 2 ? w00.z : w00.w));
          const float wb1 = e == 0 ? w01.x : (e == 1 ? w01.y : (e == 2 ? w01.z : w01.w));
          const float ab0 = e == 0 ? a00.x : (e == 1 ? a00.y : (e == 2 ? a00.z : a00.w));
          const float ab1 = e == 0 ? a01.x : (e == 1 ? a01.y : (e == 2 ? a01.z : a01.w));
#pragma unroll
          for (int z = 0; z < 2; ++z) {
            const float wv = z == 0 ? wb0 + aw0[e] : wb1 + aw1[e];
            const float ee = 0.60653066f * sigmoidf_(wv);
            const float dpv = 1.0f - __expf(-ee);
            const float av = sigmoidf_(z == 0 ? ab0 + aa0[e] : ab1 + aa1[e]);
            if (z == 0) { dp0[e] = dpv; az0[e] = av; } else { dp1[e] = dpv; az1[e] = av; }
          }
        }
        uint2 w;
        w.x = pack2(dp0[0], dp0[1]); w.y = pack2(dp0[2], dp0[3]);
        *(uint2*)(DP + row * 512 + c4) = w;
        w.x = pack2(dp1[0], dp1[1]); w.y = pack2(dp1[2], dp1[3]);
        *(uint2*)(DP + (SZ512 / 2) + row * 512 + c4) = w;
        w.x = pack2(az0[0], az0[1]); w.y = pack2(az0[2], az0[3]);
        *(uint2*)(AZ + row * 512 + c4) = w;
        w.x = pack2(az1[0], az1[1]); w.y = pack2(az1[2], az1[3]);
        *(uint2*)(AZ + (SZ512 / 2) + row * 512 + c4) = w;
        w.x = pack2(ag[0], ag[1]); w.y = pack2(ag[2], ag[3]);
        *(uint2*)(Acat + row * DM + 512 + c4) = w;
      }
    }
    __syncthreads();
    {
      const int c8 = (tid & 63) * 8, tk = tid >> 6;
      float mr[8], mk[8], mv[8], kc[8];
#pragma unroll
      for (int q = 0; q < 8; ++q) { mr[q] = mu[c8 + q]; mk[q] = mu[512 + c8 + q]; mv[q] = mu[1024 + c8 + q]; kc[q] = P.d_k_k[c8 + q]; }
#pragma unroll 2
      for (int pass = 0; pass < PREP_T / 4; ++pass) {
        const int k = pass * 4 + tk;
        const int kidx = k0 + k;
        const size_t row = (size_t)(row0 + k);
        const bool hp = (kidx != 0 && kidx != 256), hn = (kidx != 255 && kidx != TPB - 1);
        uint4 xc[3], xpv[3], xnv[3];
#pragma unroll
        for (int q = 0; q < 3; ++q) {
          xc[q] = *(const uint4*)(RAW + row * 1536 + q * 512 + c8);
          xpv[q] = hp ? *(const uint4*)(RAW + (row - 1) * 1536 + q * 512 + c8) : make_uint4(0u, 0u, 0u, 0u);
          xnv[q] = hn ? *(const uint4*)(RAW + (row + 1) * 1536 + q * 512 + c8) : make_uint4(0u, 0u, 0u, 0u);
        }
        float xs[3][8];
#pragma unroll
        for (int q = 0; q < 3; ++q) {
          const uint32_t cw[4] = {xc[q].x, xc[q].y, xc[q].z, xc[q].w};
          const uint32_t pw[4] = {xpv[q].x, xpv[q].y, xpv[q].z, xpv[q].w};
          const uint32_t nw[4] = {xnv[q].x, xnv[q].y, xnv[q].z, xnv[q].w};
#pragma unroll
          for (int w = 0; w < 4; ++w) {
            const float x0 = __uint_as_float(cw[w] << 16), x1 = __uint_as_float(cw[w] & 0xffff0000u);
            const float p0 = __uint_as_float(pw[w] << 16), p1 = __uint_as_float(pw[w] & 0xffff0000u);
            const float n0 = __uint_as_float(nw[w] << 16), n1 = __uint_as_float(nw[w] & 0xffff0000u);
            const float m0 = q == 0 ? mr[2 * w] : (q == 1 ? mk[2 * w] : mv[2 * w]);
            const float m1 = q == 0 ? mr[2 * w + 1] : (q == 1 ? mk[2 * w + 1] : mv[2 * w + 1]);
            xs[q][2 * w] = x0 + m0 * (0.5f * (p0 + n0) - x0);
            xs[q][2 * w + 1] = x1 + m1 * (0.5f * (p1 + n1) - x1);
          }
        }
        *(uint4*)(XR + row * 512 + c8) = make_uint4(pack2(xs[0][0], xs[0][1]), pack2(xs[0][2], xs[0][3]), pack2(xs[0][4], xs[0][5]), pack2(xs[0][6], xs[0][7]));
        *(uint4*)(XK + row * 512 + c8) = make_uint4(pack2(xs[1][0], xs[1][1]), pack2(xs[1][2], xs[1][3]), pack2(xs[1][4], xs[1][5]), pack2(xs[1][6], xs[1][7]));
        *(uint4*)(XV + row * 512 + c8) = make_uint4(pack2(xs[2][0], xs[2][1]), pack2(xs[2][2], xs[2][3]), pack2(xs[2][4], xs[2][5]), pack2(xs[2][6], xs[2][7]));
        float kv[8], ss = 0.f;
#pragma unroll
        for (int q = 0; q < 8; ++q) { kv[q] = xs[1][q] * kc[q]; ss += kv[q] * kv[q]; }
        ss += dppf8(ss, 0);
        ss += dppf8(ss, 1);
        ss += dppf8(ss, 2);
        const float inv = 1.0f / fmaxf(sqrtf(ss), 1e-12f);
        *(uint4*)(KK + row * 512 + c8) = make_uint4(pack2(kv[0] * inv, kv[1] * inv), pack2(kv[2] * inv, kv[3] * inv),
                                                   pack2(kv[4] * inv, kv[5] * inv), pack2(kv[6] * inv, kv[7] * inv));
      }
    }
  }
}

__device__ __forceinline__ float dppf(float x, const int ctrl_sel) {
  int xi = __float_as_int(x), r;
  if (ctrl_sel == 0) r = __builtin_amdgcn_update_dpp(0, xi, 0xB1, 0xF, 0xF, true);
  else if (ctrl_sel == 1) r = __builtin_amdgcn_update_dpp(0, xi, 0x4E, 0xF, 0xF, true);
  else if (ctrl_sel == 2) r = __builtin_amdgcn_update_dpp(0, xi, 0x141, 0xF, 0xF, true);
  else r = __builtin_amdgcn_update_dpp(0, xi, 0x140, 0xF, 0xF, true);
  return __int_as_float(r);
}
__device__ __forceinline__ float red16(float x) {
  x += dppf(x, 0);
  x += dppf(x, 1);
  x += dppf(x, 2);
  x += dppf(x, 3);
  return x;
}

__device__ __forceinline__ void phase_scan(const Params& P, char* smem) {
  const int kloc = blockIdx.x >> 3;
  if ((kloc & 1) || kloc >= 32) return;
  const int widx = (kloc >> 1) * 8 + (blockIdx.x & 7);
  char* ws = P.ws;
  const int chain = widx >> 2, rg = widx & 3;
  const int z = chain >> 4, b = (chain >> 3) & 1, h = chain & 7;
  const bf16_t* XR = (const bf16_t*)(ws + OFF_XR);
  const bf16_t* XK = (const bf16_t*)(ws + OFF_XK);
  const bf16_t* XV = (const bf16_t*)(ws + OFF_XV);
  const bf16_t* KK = (const bf16_t*)(ws + OFF_KK);
  const bf16_t* DP = (const bf16_t*)(ws + OFF_DP) + (size_t)z * (SZ512 / 2);
  const bf16_t* AZ = (const bf16_t*)(ws + OFF_AZ) + (size_t)z * (SZ512 / 2);
  bf16_t* YZ = (bf16_t*)(ws + OFF_YZ) + (size_t)z * (SZ512 / 2);
  float* buf = (float*)smem;
  const int tid = threadIdx.x;
  const int rowl = tid >> 4, kq = tid & 15;
  const int vrow = rg * 16 + rowl;
  const int sl = tid >> 4, k4 = (tid & 15) * 4;
  float ka[4];
#pragma unroll
  for (int i = 0; i < 4; ++i) ka[i] = P.d_k_a[h * 64 + k4 + i];
  f32x2 S01 = (f32x2){0.f, 0.f}, S23 = (f32x2){0.f, 0.f};
  uint2 g_r[2], g_k[2], g_v[2], g_kk[2], g_dp[2], g_az[2];
  auto kidx_of = [&](int n) { return z == 0 ? n : (n < 256 ? 255 - n : 16895 - n); };
#define SCAN_GLOAD(ci_)                                                              \
  _Pragma("unroll") for (int hh = 0; hh < 2; ++hh) {                                 \
    const int kidx = kidx_of((ci_) * 32 + hh * 16 + sl);                             \
    const size_t off = (size_t)(b * TPB + kidx) * 512 + h * 64 + k4;                 \
    g_r[hh] = *(const uint2*)(XR + off);                                             \
    g_k[hh] = *(const uint2*)(XK + off);                                             \
    g_v[hh] = *(const uint2*)(XV + off);                                             \
    g_kk[hh] = *(const uint2*)(KK + off);                                            \
    g_dp[hh] = *(const uint2*)(DP + off);                                            \
    g_az[hh] = *(const uint2*)(AZ + off);                                            \
  }
  SCAN_GLOAD(0)
  const int nchunks = TPB / 32;
  for (int ci = 0; ci < nchunks; ++ci) {
#pragma unroll
    for (int hh = 0; hh < 2; ++hh) {
      float r[4], k[4], v[4], kk[4], dp[4], az[4];
      r[0] = __uint_as_float(g_r[hh].x << 16); r[1] = __uint_as_float(g_r[hh].x & 0xffff0000u);
      r[2] = __uint_as_float(g_r[hh].y << 16); r[3] = __uint_as_float(g_r[hh].y & 0xffff0000u);
      k[0] = __uint_as_float(g_k[hh].x << 16); k[1] = __uint_as_float(g_k[hh].x & 0xffff0000u);
      k[2] = __uint_as_float(g_k[hh].y << 16); k[3] = __uint_as_float(g_k[hh].y & 0xffff0000u);
      v[0] = __uint_as_float(g_v[hh].x << 16); v[1] = __uint_as_float(g_v[hh].x & 0xffff0000u);
      v[2] = __uint_as_float(g_v[hh].y << 16); v[3] = __uint_as_float(g_v[hh].y & 0xffff0000u);
      kk[0] = __uint_as_float(g_kk[hh].x << 16); kk[1] = __uint_as_float(g_kk[hh].x & 0xffff0000u);
      kk[2] = __uint_as_float(g_kk[hh].y << 16); kk[3] = __uint_as_float(g_kk[hh].y & 0xffff0000u);
      dp[0] = __uint_as_float(g_dp[hh].x << 16); dp[1] = __uint_as_float(g_dp[hh].x & 0xffff0000u);
      dp[2] = __uint_as_float(g_dp[hh].y << 16); dp[3] = __uint_as_float(g_dp[hh].y & 0xffff0000u);
      az[0] = __uint_as_float(g_az[hh].x << 16); az[1] = __uint_as_float(g_az[hh].x & 0xffff0000u);
      az[2] = __uint_as_float(g_az[hh].y << 16); az[3] = __uint_as_float(g_az[hh].y & 0xffff0000u);
      float* bp = buf + (hh * 16 + sl) * 384 + k4;
      *(float4*)(bp + 0) = make_float4(r[0], r[1], r[2], r[3]);
      *(float4*)(bp + 64) = make_float4(1.f - dp[0], 1.f - dp[1], 1.f - dp[2], 1.f - dp[3]);
      *(float4*)(bp + 128) = make_float4(k[0] * (1.f + (az[0] - 1.f) * ka[0]), k[1] * (1.f + (az[1] - 1.f) * ka[1]),
                                         k[2] * (1.f + (az[2] - 1.f) * ka[2]), k[3] * (1.f + (az[3] - 1.f) * ka[3]));
      *(float4*)(bp + 192) = make_float4(v[0], v[1], v[2], v[3]);
      *(float4*)(bp + 256) = make_float4(-kk[0], -kk[1], -kk[2], -kk[3]);
      *(float4*)(bp + 320) = make_float4(kk[0] * az[0], kk[1] * az[1], kk[2] * az[2], kk[3] * az[3]);
    }
    __syncthreads();
    if (ci + 1 < nchunks) { SCAN_GLOAD(ci + 1) }
    float ykeep0 = 0.f, ykeep1 = 0.f;
    f32x4 Lr[2][2], Lw[2][2], Lk[2][2], La[2][2], Lb[2][2];
    float Lv[2][2];
#define SCAN_LOADB(j_, slot_)                                               \
  _Pragma("unroll") for (int u = 0; u < 2; ++u) {                           \
    const float* bp = buf + ((j_) * 2 + u) * 384 + kq * 4;                  \
    Lr[slot_][u] = *(const f32x4*)(bp + 0);                                 \
    Lw[slot_][u] = *(const f32x4*)(bp + 64);                                \
    Lk[slot_][u] = *(const f32x4*)(bp + 128);                               \
    Lv[slot_][u] = buf[((j_) * 2 + u) * 384 + 192 + vrow];                  \
    La[slot_][u] = *(const f32x4*)(bp + 256);                               \
    Lb[slot_][u] = *(const f32x4*)(bp + 320);                               \
  }
    SCAN_LOADB(0, 0)
    float yprev = 0.f;
#pragma unroll
    for (int j = 0; j < 16; ++j) {
      if (j + 1 < 16) {
        SCAN_LOADB(j + 1, (j + 1) & 1)
      }
      __builtin_amdgcn_sched_barrier(0);
#pragma unroll
      for (int u = 0; u < 2; ++u) {
        const int sl2 = j & 1;
        const int st = j * 2 + u;
        const f32x4 a4 = La[sl2][u], b4 = Lb[sl2][u], w4 = Lw[sl2][u], kd = Lk[sl2][u], r4 = Lr[sl2][u];
        const float vv = Lv[sl2][u];
        f32x2 p = S01 * a4.xy;
        p = S23 * a4.zw + p;
        float sa = p.x + p.y;
        sa += dppf(sa, 0); yprev += dppf(yprev, 0);
        sa += dppf(sa, 1); yprev += dppf(yprev, 1);
        sa += dppf(sa, 2); yprev += dppf(yprev, 2);
        sa += dppf(sa, 3); yprev += dppf(yprev, 3);
        if (st >= 1 && st <= 16) ykeep0 = (kq == st - 1) ? yprev : ykeep0;
        if (st >= 17) ykeep1 = (kq == st - 17) ? yprev : ykeep1;
        const f32x2 sa2 = (f32x2){sa, sa}, vv2 = (f32x2){vv, vv};
        const f32x2 t01 = sa2 * b4.xy + vv2 * kd.xy;
        const f32x2 t23 = sa2 * b4.zw + vv2 * kd.zw;
        S01 = S01 * w4.xy + t01;
        S23 = S23 * w4.zw + t23;
        f32x2 q = S01 * r4.xy;
        q = S23 * r4.zw + q;
        yprev = q.x + q.y;
      }
    }
    yprev = red16(yprev);
    ykeep1 = (kq == 15) ? yprev : ykeep1;
    {
      const int kidx0 = kidx_of(ci * 32 + kq), kidx1 = kidx_of(ci * 32 + 16 + kq);
      YZ[(size_t)(b * TPB + kidx0) * 512 + h * 64 + rg * 16 + rowl] = f2bf(ykeep0);
      YZ[(size_t)(b * TPB + kidx1) * 512 + h * 64 + rg * 16 + rowl] = f2bf(ykeep1);
    }
    __syncthreads();
  }
}

__device__ __forceinline__ float red8(float x) {
  x += dppf8(x, 0);
  x += dppf8(x, 1);
  x += dppf8(x, 2);
  return x;
}
__device__ __forceinline__ void unpack8(const uint4 g, float (&o)[8]) {
  o[0] = __uint_as_float(g.x << 16); o[1] = __uint_as_float(g.x & 0xffff0000u);
  o[2] = __uint_as_float(g.y << 16); o[3] = __uint_as_float(g.y & 0xffff0000u);
  o[4] = __uint_as_float(g.z << 16); o[5] = __uint_as_float(g.z & 0xffff0000u);
  o[6] = __uint_as_float(g.w << 16); o[7] = __uint_as_float(g.w & 0xffff0000u);
}
__device__ __forceinline__ void phase_rwkv_out(const Params& P) {
  char* ws = P.ws;
  const bf16_t* XR = (const bf16_t*)(ws + OFF_XR);
  const bf16_t* XK = (const bf16_t*)(ws + OFF_XK);
  const bf16_t* XV = (const bf16_t*)(ws + OFF_XV);
  const bf16_t* AZ = (const bf16_t*)(ws + OFF_AZ);
  const bf16_t* YZ = (const bf16_t*)(ws + OFF_YZ);
  bf16_t* Acat = (bf16_t*)(ws + OFF_A);
  const int lane = threadIdx.x & 63, wave = threadIdx.x >> 6;
  const int c8 = lane * 8;
  float lw[8], lb[8], kav[8], rkv[8];
#pragma unroll
  for (int q = 0; q < 8; ++q) { lw[q] = P.d_ln_w[c8 + q]; lb[q] = P.d_ln_b[c8 + q]; kav[q] = P.d_k_a[c8 + q]; rkv[q] = P.d_r_k[c8 + q]; }
#pragma unroll 2
  for (int idx = blockIdx.x * 4 + wave; idx < 32768; idx += gridDim.x * 4) {
    const size_t row = (size_t)((idx >> 14) * TPB + 256 + (idx & 16383));
    const size_t off = row * 512 + c8;
    const uint4 u_y0 = *(const uint4*)(YZ + off), u_y1 = *(const uint4*)(YZ + (SZ512 / 2) + off);
    const uint4 u_r = *(const uint4*)(XR + off), u_k = *(const uint4*)(XK + off), u_v = *(const uint4*)(XV + off);
    const uint4 u_a0 = *(const uint4*)(AZ + off), u_a1 = *(const uint4*)(AZ + (SZ512 / 2) + off);
    const uint4 u_g = *(const uint4*)(Acat + row * DM + 512 + c8);
    float y0[8], y1[8], rr[8], kk_[8], vv[8], a0[8], a1[8], gg[8];
    unpack8(u_y0, y0); unpack8(u_y1, y1); unpack8(u_r, rr); unpack8(u_k, kk_); unpack8(u_v, vv);
    unpack8(u_a0, a0); unpack8(u_a1, a1); unpack8(u_g, gg);
    float y[8], sy = 0.f, sd = 0.f;
#pragma unroll
    for (int q = 0; q < 8; ++q) {
      y[q] = y0[q] + y1[q];
      sy += y[q];
      const float kd = kk_[q] * (1.f + (a0[q] - 1.f) * kav[q]) + kk_[q] * (1.f + (a1[q] - 1.f) * kav[q]);
      sd += rr[q] * kd * rkv[q];
    }
    const float mean = red8(sy) * (1.0f / 64.0f);
    const float sdot = red8(sd);
    float sv = 0.f;
#pragma unroll
    for (int q = 0; q < 8; ++q) { y[q] -= mean; sv += y[q] * y[q]; }
    const float rstd = rsqrtf(red8(sv) * (1.0f / 64.0f) + 64e-5f);
    float o[8];
#pragma unroll
    for (int q = 0; q < 8; ++q) o[q] = (y[q] * rstd * lw[q] + lb[q] + sdot * vv[q]) * gg[q];
    *(uint4*)(Acat + row * DM + 512 + c8) = make_uint4(pack2(o[0], o[1]), pack2(o[2], o[3]), pack2(o[4], o[5]), pack2(o[6], o[7]));
  }
}

#define XB_TMO      128
#define XB_XCNT(j)  (256  + 64 * (j))
#define XB_XSUB(j)  (1280 + 64 * (j))
#define XB_XGEN(j)  (2304 + 64 * (j))
#define XB_TOP      3328
#define XB_TOPGEN   3392
#define XCD_BAR_WORDS 3456
#define XB_SPIN_CAP (1u << 22)
#define LAS __attribute__((address_space(3)))
__device__ __forceinline__ unsigned xb_ld(unsigned* p) { return __hip_atomic_load(p, __ATOMIC_RELAXED, __HIP_MEMORY_SCOPE_AGENT); }
__device__ __forceinline__ unsigned xb_add(unsigned* p, unsigned v) { return __hip_atomic_fetch_add(p, v, __ATOMIC_RELAXED, __HIP_MEMORY_SCOPE_AGENT); }
__device__ __forceinline__ unsigned xb_xcc_id() { return (unsigned)__builtin_amdgcn_s_getreg((3 << 11) | 20) & 0xFu; }
#define XB_SPIN(cond, bar) do { unsigned _sp = 0; while (cond) { __builtin_amdgcn_s_sleep(1); \
    if ((++_sp & 255u) == 0u) { if (xb_ld(&(bar)[XB_TMO])) break; if (_sp > XB_SPIN_CAP) { atomicAdd(&(bar)[XB_TMO], 1u); break; } } } } while (0)
struct XcdBarrier { unsigned* bar; unsigned x; volatile LAS unsigned* st; };
__device__ __forceinline__ XcdBarrier xcd_barrier_post(unsigned* bar, volatile LAS unsigned* st) {
  XcdBarrier b; b.bar = bar; b.x = xb_xcc_id(); b.st = st;
  if (threadIdx.x == 0) (void)xb_add(&bar[XB_XCNT(b.x)], 1u);
  return b;
}
__device__ __forceinline__ void xcd_barrier_complete(unsigned* bar, unsigned x, unsigned& nloc, unsigned& nx) {
  const unsigned G = gridDim.x * gridDim.y * gridDim.z;
  unsigned sum, cnt, mine, sp = 0u;
  for (;;) {
    sum = 0u; cnt = 0u; mine = 0u;
#pragma unroll
    for (unsigned j = 0; j < 16; ++j) { const unsigned c = xb_ld(&bar[XB_XCNT(j)]); sum += c; cnt += (c > 0u) ? 1u : 0u; mine = (j == x) ? c : mine; }
    if (sum == G) break;
    __builtin_amdgcn_s_sleep(1);
    if ((++sp & 255u) == 0u) { if (xb_ld(&bar[XB_TMO])) break; if (sp > XB_SPIN_CAP) { atomicAdd(&bar[XB_TMO], 1u); break; } }
  }
  nloc = mine > 0u ? mine : 1u; nx = cnt > 0u ? cnt : 1u;
}
__device__ __forceinline__ void xcd_barrier(const XcdBarrier& b) {
  asm volatile("s_waitcnt vmcnt(0)" ::: "memory");
  __syncthreads();
  if (threadIdx.x == 0) {
    unsigned* bar = b.bar;
    __builtin_amdgcn_s_waitcnt(0);
    unsigned nloc = b.st[0], nx = b.st[1];
    if (nloc == 0u) { xcd_barrier_complete(bar, b.x, nloc, nx); b.st[0] = nloc; b.st[1] = nx; }
    const unsigned old = xb_add(&bar[XB_XSUB(b.x)], 1u);
    const unsigned gen = old / nloc;
    if (old + 1u == (gen + 1u) * nloc) {
      __builtin_amdgcn_fence(__ATOMIC_RELEASE, "agent");
      asm volatile("s_waitcnt vmcnt(0)" ::: "memory");
      const unsigned og = xb_add(&bar[XB_TOP], 1u);
      const unsigned tg = og / nx;
      if (og + 1u == (tg + 1u) * nx) xb_add(&bar[XB_TOPGEN], 1u);
      else XB_SPIN(xb_ld(&bar[XB_TOPGEN]) == tg, bar);
      __builtin_amdgcn_fence(__ATOMIC_ACQUIRE, "agent");
      xb_add(&bar[XB_XGEN(b.x)], 1u);
      asm volatile("s_waitcnt vmcnt(0)" ::: "memory");
    } else {
      XB_SPIN(xb_ld(&bar[XB_XGEN(b.x)]) == gen, bar);
      __builtin_amdgcn_fence(__ATOMIC_ACQUIRE, "agent");
      asm volatile("s_waitcnt vmcnt(0)" ::: "memory");
    }
  }
  __syncthreads();
}

#define NPHASE 18
__device__ __forceinline__ void run_phase(const Params& P, int ph, char* smem) {
  char* ws = P.ws;
  bf16_t* A = (bf16_t*)(ws + OFF_A);
  float* xctx = (float*)(ws + OFF_XCTX);
  const float* mod0 = (const float*)(ws + OFF_MOD);
  const float* mod1 = mod0 + 3 * 6144;
  const bf16_t* WIN = (const bf16_t*)(ws + OFF_WIN);
  const bf16_t* WOUT = (const bf16_t*)(ws + OFF_WOUT);
  const bf16_t* WGU = (const bf16_t*)(ws + OFF_WGU);
  const bf16_t* WDN = (const bf16_t*)(ws + OFF_WDN);
  bf16_t* ACT = (bf16_t*)(ws + OFF_ACT);
  switch (ph) {
    case 0:
      phase_conv(P, 0, smem, 0, blockIdx.x, gridDim.x);
      phase_adaln(P, smem);
      break;
    case 1:
      phase_norm(P.x, P.ctx, P.norm_mix, mod0, 0, 1024, A, false);
      break;
    case 2: {
      EpiIn0 e;
      e.a_qn = P.a_qn; e.a_kn = P.a_kn; e.b_qn = P.b_qn; e.b_kn = P.b_kn;
      e.rope = (const float*)(ws + OFF_ROPE);
      e.AQ = (bf16_t*)(ws + OFF_AQ); e.AK = (bf16_t*)(ws + OFF_AK); e.AVT = (bf16_t*)(ws + OFF_AVT);
      e.BQ = (bf16_t*)(ws + OFF_BQ); e.BK = (bf16_t*)(ws + OFF_BK); e.BVT = (bf16_t*)(ws + OFF_BVT);
      gemm_phase<false>(A, DM, WIN, 1024, 18, false, e, smem);
    } break;
    case 3:
      phase_attn0(P, smem);
      break;
    case 4: {
      EpiRes e;
      e.lat_src = P.x; e.ctx_src = P.ctx; e.lat_dst = P.out; e.ctx_dst = xctx; e.gate = mod0 + 2048;
      gemm_phase<true>(A, DM, WOUT, 1024, 8, false, e, smem);
    } break;
    case 5:
      phase_norm(P.out, xctx, P.norm_ffn, mod0, 3072, 4096, A, false);
      break;
    case 6: {
      EpiGU e;
      e.ACT = ACT;
      gemm_phase<true>(A, DM, WGU, 1024, 44, false, e, smem);
    } break;
    case 7: {
      EpiRes e;
      e.lat_src = P.out; e.ctx_src = xctx; e.lat_dst = P.out; e.ctx_dst = xctx; e.gate = mod0 + 5120;
      gemm_phase<true>(ACT, DFF, WDN, DFF, 8, false, e, smem);
    } break;
    case 8:
      phase_conv(P, 1, smem, 1, blockIdx.x, gridDim.x);
      phase_lora_conv(P);
      phase_norm(P.out, xctx, P.norm_mix + 1024, mod1, 0, 1024, A, false);
      break;
    case 9: {
      EpiIn1 e;
      e.c_qn = P.c_qn; e.c_kn = P.c_kn;
      e.CQ = (bf16_t*)(ws + OFF_CQ); e.CK = (bf16_t*)(ws + OFF_CK); e.CVT = (bf16_t*)(ws + OFF_CVT);
      e.RAW = (bf16_t*)(ws + OFF_RAW); e.LORA = (float*)(ws + OFF_LORA);
      gemm_phase<false>(A, DM, WIN, 1024, 26, false, e, smem);
    } break;
    case 10:
      phase_na(P, smem);
      break;
    case 11:
      phase_prep(P, smem);
      break;
    case 12: {
      const int kloc = blockIdx.x >> 3;
      const bool is_scan = !((kloc & 1) || kloc >= 32);
      if (is_scan) phase_scan(P, smem);
      else {
        const int kc = kloc < 32 ? kloc : 32;
        phase_conv(P, 1, smem, 2, (int)blockIdx.x - 8 * ((kc + 1) >> 1), (int)gridDim.x - 128);
      }
    } break;
    case 13:
      phase_rwkv_out(P);
      break;
    case 14: {
      EpiRes e;
      e.lat_src = P.out; e.ctx_src = xctx; e.lat_dst = P.out; e.ctx_dst = xctx; e.gate = mod1 + 2048;
      gemm_phase<true>(A, DM, WOUT, 1024, 8, true, e, smem);
    } break;
    case 15:
      phase_norm(P.out, xctx, P.norm_ffn + 1024, mod1, 3072, 4096, A, true);
      break;
    case 16: {
      EpiGU e;
      e.ACT = ACT;
      gemm_phase<true>(A, DM, WGU, 1024, 44, true, e, smem);
    } break;
    case 17: {
      EpiRes e;
      e.lat_src = P.out; e.ctx_src = xctx; e.lat_dst = P.out; e.ctx_dst = xctx; e.gate = mod1 + 5120;
      gemm_phase<true>(ACT, DFF, WDN, DFF, 8, true, e, smem);
    } break;
    default: break;
  }
}

#define SMEM_BYTES 49152

#if MEGA
template <int PH>
__device__ __forceinline__ void run_all(const Params& P, char* smem, cg::grid_group& grid, const XcdBarrier& xb) {
  run_phase(P, PH, smem);
  if constexpr (((DUP_MASK >> PH) & 1) != 0) {
    xcd_barrier(xb);
    run_phase(P, PH, smem);
  }
  if constexpr (PH + 1 < NPHASE) {
    if constexpr (PH == 0) grid.sync(); else xcd_barrier(xb);
    run_all<PH + 1>(P, smem, grid, xb);
  }
}
__global__ void __launch_bounds__(256, 2) fwd_mega(Params P) {
  extern __shared__ __attribute__((aligned(16))) char smem[];
  __shared__ uint4 xb_words;
  cg::grid_group grid = cg::this_grid();
  if (threadIdx.x == 0) xb_words = make_uint4(0u, 0u, 0u, 0u);
  __syncthreads();
  XcdBarrier xb = xcd_barrier_post((unsigned*)(P.ws + OFF_BAR), (volatile LAS unsigned*)&xb_words);
  run_all<0>(P, smem, grid, xb);
}
#else
template <int PH>
__global__ void __launch_bounds__(256, 2) fwd_phase(Params P) {
  extern __shared__ __attribute__((aligned(16))) char smem[];
  run_phase(P, PH, smem);
}
template <int PH>
static void launch_all(const Params& P, hipStream_t stream) {
  fwd_phase<PH><<<512, 256, SMEM_BYTES, stream>>>(P);
  if constexpr (PH + 1 < NPHASE) launch_all<PH + 1>(P, stream);
}
#endif

extern "C" void kernel_launch(void* const* d_in, const int* in_sizes, int n_in, void* d_out, int out_size, void* d_ws,
                              size_t ws_size, hipStream_t stream) {
  if (ws_size < WS_NEEDED) {
    fprintf(stderr, "workspace too small: %zu < %llu\n", ws_size, (unsigned long long)WS_NEEDED);
    return;
  }
  Params P{};
  const float** pp = (const float**)&P;
  for (int i = 0; i < 36; ++i) pp[i] = (const float*)d_in[i];
  P.out = (float*)d_out;
  P.ws = (char*)d_ws;
#if MEGA
  static int grid_blocks = 0;
  if (!grid_blocks) {
    int dev = 0, cus = 0, per_cu = 0;
    hipGetDevice(&dev);
    hipDeviceGetAttribute(&cus, hipDeviceAttributeMultiprocessorCount, dev);
    hipFuncSetAttribute((const void*)fwd_mega, hipFuncAttributeMaxDynamicSharedMemorySize, SMEM_BYTES);
    hipOccupancyMaxActiveBlocksPerMultiprocessor(&per_cu, fwd_mega, 256, SMEM_BYTES);
    if (per_cu > 2) per_cu = 2;
    grid_blocks = cus * per_cu;
  }
  hipMemsetAsync((char*)d_ws + OFF_BAR, 0, XCD_BAR_WORDS * sizeof(unsigned), stream);
  void* args[] = {&P};
  hipError_t e = hipLaunchCooperativeKernel((void*)fwd_mega, dim3(grid_blocks), dim3(256), args, SMEM_BYTES, stream);
  if (e != hipSuccess) fprintf(stderr, "cooperative launch failed: %s (grid %d)\n", hipGetErrorString(e), grid_blocks);
#else
  launch_all<0>(P, stream);
#endif
}
```

```cpp
#include <hip/hip_runtime.h>
#include <hip/hip_cooperative_groups.h>
#include <stdint.h>
#include <stdio.h>

namespace cg = cooperative_groups;

#ifndef MEGA
#define MEGA 1
#endif
#define DUP_MASK 0

typedef unsigned short bf16_t;
typedef short bf16x8 __attribute__((ext_vector_type(8)));
typedef short bf16x4 __attribute__((ext_vector_type(4)));
typedef float f32x4 __attribute__((ext_vector_type(4)));
typedef float f32x2 __attribute__((ext_vector_type(2)));

#define DM 1024
#define TPB 16640
#define MROWS 33280
#define DFF 2816
#define LOG2E 1.4426950408889634f
#define LSTR 80

#define OFF_WIN   0ull
#define OFF_WOUT  6815744ull
#define OFF_WGU   8912896ull
#define OFF_WDN   20447232ull
#define OFF_MISC  26214400ull
#define OFF_MOD   (OFF_MISC)
#define OFF_ROPE  (OFF_MISC + 147456ull)
#define OFF_LAM   (OFF_MISC + 180224ull)
#define OFF_BAR   (OFF_MISC + 196608ull)
#define OFF_XCTX  (OFF_MISC + 262144ull)
#define OFF_WL    (OFF_MISC + 2359296ull)
#define OFF_A     (OFF_MISC + 4194304ull)
#define OFF_BIG   (OFF_A + 68157440ull)
#define SZ512     34078720ull
#define OFF_AQ    (OFF_BIG)
#define OFF_AK    (OFF_BIG + SZ512)
#define OFF_AVT   (OFF_BIG + 2 * SZ512)
#define OFF_BQ    (OFF_BIG + 3 * SZ512)
#define OFF_BK    (OFF_BIG + 4 * SZ512)
#define OFF_BVT   (OFF_BK + 8519680ull)
#define OFF_ACT   (OFF_BIG)
#define OFF_RAW   (OFF_BIG)
#define OFF_LORA  (OFF_BIG + 102236160ull)
#define OFF_D0    (OFF_BIG + 132055040ull)
#define OFF_CQ    (OFF_D0)
#define OFF_CK    (OFF_D0 + SZ512)
#define OFF_CVT   (OFF_D0 + 2 * SZ512)
#define OFF_XR    (OFF_D0)
#define OFF_XK    (OFF_D0 + 1 * SZ512)
#define OFF_XV    (OFF_D0 + 2 * SZ512)
#define OFF_KK    (OFF_D0 + 3 * SZ512)
#define OFF_DP    (OFF_D0 + 4 * SZ512)
#define OFF_AZ    (OFF_D0 + 6 * SZ512)
#define OFF_YZ    (OFF_BIG)
#define WS_NEEDED (OFF_D0 + 8 * SZ512)

struct Params {
  const float *x, *c, *ctx, *c_ctx, *ada_w, *ada_b, *norm_mix, *norm_ffn, *w_gate, *w_up, *w_down,
      *ab_w_in, *ab_w_out, *a_qn, *a_kn, *a_lambda, *a_subln, *b_qn, *b_kn, *b_sink,
      *cd_w_in, *cd_w_out, *c_qn, *c_kn, *c_rpb, *d_mu, *d_w0, *d_w2, *d_a0, *d_a2, *d_g2,
      *d_k_k, *d_k_a, *d_r_k, *d_ln_w, *d_ln_b;
  float* out;
  char* ws;
};

__device__ __forceinline__ bf16_t f2bf(float f) {
  uint32_t u = __float_as_uint(f);
  u += 0x7fffu + ((u >> 16) & 1u);
  return (bf16_t)(u >> 16);
}
__device__ __forceinline__ float bf2f(bf16_t h) { return __uint_as_float(((uint32_t)h) << 16); }
typedef __bf16 bf16v2_t __attribute__((ext_vector_type(2)));
__device__ __forceinline__ uint32_t pack2(float a, float b) {
  const f32x2 v = (f32x2){a, b};
  const bf16v2_t r = __builtin_convertvector(v, bf16v2_t);
  return __builtin_bit_cast(uint32_t, r);
}
__device__ __forceinline__ float fexp2(float x) { return __builtin_amdgcn_exp2f(x); }
__device__ __forceinline__ float wave_sum(float v) {
#pragma unroll
  for (int o = 32; o >= 1; o >>= 1) v += __shfl_xor(v, o);
  return v;
}
__device__ __forceinline__ float sigmoidf_(float x) { return __builtin_amdgcn_rcpf(1.0f + __expf(-x)); }

template <bool DEEP, class Epi>
__device__ __forceinline__ void gemm_phase(const bf16_t* __restrict__ A, int lda, const bf16_t* __restrict__ Wt,
                                           int K, int ntn, bool lat_only, const Epi& epi, char* smem) {
  bf16_t* sA = (bf16_t*)smem;
  bf16_t* sB = sA + 128 * LSTR;
  int tid = threadIdx.x;
  asm volatile("" : "+v"(tid));
  const int lane = tid & 63, wave = tid >> 6;
  const int wm = wave >> 1, wn = wave & 1;
  const int l15 = lane & 15, quad = lane >> 4;
  const int ntm = lat_only ? 256 : 260;
  const int total = ntm * ntn;
  const int lr = tid >> 3, lc = (tid & 7) * 8;
  const bool swz = (gridDim.x & 7) == 0;
  const int xcd = swz ? (blockIdx.x & 7) : 0, lb = swz ? (blockIdx.x >> 3) : blockIdx.x, nlb = swz ? (gridDim.x >> 3) : gridDim.x;
  const int m_lo = swz ? (ntm * xcd) / 8 : 0, m_hi = swz ? (ntm * (xcd + 1)) / 8 : ntm;
  const int nm = m_hi - m_lo;
  const int total_x = nm * ntn;
  (void)total;
  for (int t = lb; t < total_x; t += nlb) {
    const int g = t / (8 * ntn), r = t - g * 8 * ntn;
    const int gsz = min(8, nm - g * 8);
    const int ni = r / gsz, mm = r - ni * gsz;
    const int mi = m_lo + g * 8 + mm;
    const int mt = lat_only ? ((mi >> 7) * 130 + 2 + (mi & 127)) : mi;
    const int row0 = mt * 128, col0 = ni * 128;
    const bf16_t* Ap = A + (size_t)(row0 + lr) * lda + lc;
    const bf16_t* Bp = Wt + (size_t)(col0 + lr) * K + lc;
    f32x4 acc[4][4];
#pragma unroll
    for (int i = 0; i < 4; ++i)
#pragma unroll
      for (int j = 0; j < 4; ++j) acc[i][j] = (f32x4){0.f, 0.f, 0.f, 0.f};
    uint4 ra0, ra1, ra2, ra3, rb0, rb1, rb2, rb3;
    uint4 rc0, rc1, rc2, rc3, rd0, rd1, rd2, rd3;
#define GEMM_LOAD(a0, a1, a2, a3, b0, b1, b2, b3, kk_)        \
  {                                                           \
    a0 = *(const uint4*)(Ap + (kk_));                         \
    a1 = *(const uint4*)(Ap + (size_t)32 * lda + (kk_));      \
    a2 = *(const uint4*)(Ap + (size_t)64 * lda + (kk_));      \
    a3 = *(const uint4*)(Ap + (size_t)96 * lda + (kk_));      \
    b0 = *(const uint4*)(Bp + (kk_));                         \
    b1 = *(const uint4*)(Bp + (size_t)32 * K + (kk_));        \
    b2 = *(const uint4*)(Bp + (size_t)64 * K + (kk_));        \
    b3 = *(const uint4*)(Bp + (size_t)96 * K + (kk_));        \
  }
#define GEMM_STORE(a0, a1, a2, a3, b0, b1, b2, b3, buf_)                   \
  {                                                                        \
    bf16_t* wa = sA + (buf_) * (256 * LSTR);                               \
    bf16_t* wb = wa + 128 * LSTR;                                          \
    *(uint4*)(wa + (lr) * LSTR + lc) = a0;                                 \
    *(uint4*)(wa + (lr + 32) * LSTR + lc) = a1;                            \
    *(uint4*)(wa + (lr + 64) * LSTR + lc) = a2;                            \
    *(uint4*)(wa + (lr + 96) * LSTR + lc) = a3;                            \
    *(uint4*)(wb + (lr) * LSTR + lc) = b0;                                 \
    *(uint4*)(wb + (lr + 32) * LSTR + lc) = b1;                            \
    *(uint4*)(wb + (lr + 64) * LSTR + lc) = b2;                            \
    *(uint4*)(wb + (lr + 96) * LSTR + lc) = b3;                            \
  }
#define GEMM_MMA(buf_, ks_)                                                                                              \
  {                                                                                                                      \
    const bf16_t* ca = sA + (buf_) * (256 * LSTR);                                                                       \
    const bf16_t* cb = ca + 128 * LSTR;                                                                                  \
    bf16x8 af[4], bfr[4];                                                                                                \
    _Pragma("unroll") for (int i = 0; i < 4; ++i)                                                                        \
        af[i] = *(const bf16x8*)(ca + (wm * 64 + i * 16 + l15) * LSTR + (ks_) * 32 + quad * 8);                         \
    _Pragma("unroll") for (int j = 0; j < 4; ++j)                                                                        \
        bfr[j] = *(const bf16x8*)(cb + (wn * 64 + j * 16 + l15) * LSTR + (ks_) * 32 + quad * 8);                        \
    _Pragma("unroll") for (int i = 0; i < 4; ++i) _Pragma("unroll") for (int j = 0; j < 4; ++j)                          \
        acc[i][j] = __builtin_amdgcn_mfma_f32_16x16x32_bf16(bfr[j], af[i], acc[i][j], 0, 0, 0);                         \
  }
    const int nk = K >> 6;
    GEMM_LOAD(ra0, ra1, ra2, ra3, rb0, rb1, rb2, rb3, 0)
    (void)rc0; (void)rc1; (void)rc2; (void)rc3; (void)rd0; (void)rd1; (void)rd2; (void)rd3;
#pragma clang loop unroll(disable)
    for (int kt = 0; kt < nk; ++kt) {
      __syncthreads();
      GEMM_STORE(ra0, ra1, ra2, ra3, rb0, rb1, rb2, rb3, 0)
      __syncthreads();
      if (kt + 1 < nk) GEMM_LOAD(ra0, ra1, ra2, ra3, rb0, rb1, rb2, rb3, (kt + 1) * 64)
      {
        bf16x8 af0[4], bf0[4], af1[4], bf1[4];
        __builtin_amdgcn_s_setprio(1);
#pragma unroll
        for (int i = 0; i < 4; ++i) af0[i] = *(const bf16x8*)(sA + (wm * 64 + i * 16 + l15) * LSTR + quad * 8);
#pragma unroll
        for (int j = 0; j < 4; ++j) bf0[j] = *(const bf16x8*)(sB + (wn * 64 + j * 16 + l15) * LSTR + quad * 8);
#pragma unroll
        for (int i = 0; i < 4; ++i) af1[i] = *(const bf16x8*)(sA + (wm * 64 + i * 16 + l15) * LSTR + 32 + quad * 8);
#pragma unroll
        for (int j = 0; j < 4; ++j) bf1[j] = *(const bf16x8*)(sB + (wn * 64 + j * 16 + l15) * LSTR + 32 + quad * 8);
        __builtin_amdgcn_sched_barrier(0);
#pragma unroll
        for (int i = 0; i < 4; ++i)
#pragma unroll
          for (int j = 0; j < 4; ++j) acc[i][j] = __builtin_amdgcn_mfma_f32_16x16x32_bf16(bf0[j], af0[i], acc[i][j], 0, 0, 0);
#pragma unroll
        for (int i = 0; i < 4; ++i)
#pragma unroll
          for (int j = 0; j < 4; ++j) acc[i][j] = __builtin_amdgcn_mfma_f32_16x16x32_bf16(bf1[j], af1[i], acc[i][j], 0, 0, 0);
        __builtin_amdgcn_s_setprio(0);
      }
    }
    asm volatile("" ::: "memory");
    epi(acc, row0 + wm * 64, col0 + wn * 64, l15, quad);
  }
}

struct EpiIn0 {
  const float *a_qn, *a_kn, *b_qn, *b_kn, *rope;
  bf16_t *AQ, *AK, *AVT, *BQ, *BK, *BVT;
  __device__ __forceinline__ void operator()(const f32x4 (&acc)[4][4], int row0w, int col0w, int l15, int quad) const {
    const int cb = col0w >> 6;
    int kind;
    const float* gain = nullptr;
    bool isq = false;
    if (cb < 8) { kind = 0; gain = a_qn; isq = true; }
    else if (cb < 16) { kind = 1; gain = a_kn; }
    else if (cb < 24) { kind = 2; }
    else if (cb < 32) { kind = 3; gain = b_qn; isq = true; }
    else if (cb < 34) { kind = 4; gain = b_kn; }
    else { kind = 5; }
#pragma unroll
    for (int i = 0; i < 4; ++i) {
      __builtin_amdgcn_sched_barrier(0);
      const int row = row0w + i * 16 + l15;
      const int b = row / TPB, kidx = row - b * TPB;
      float v[4][4];
#pragma unroll
      for (int j = 0; j < 4; ++j)
#pragma unroll
        for (int e = 0; e < 4; ++e) v[j][e] = acc[i][j][e];
      if (gain) {
        float ss = 0.f;
#pragma unroll
        for (int j = 0; j < 4; ++j)
#pragma unroll
          for (int e = 0; e < 4; ++e) ss += v[j][e] * v[j][e];
        ss += __shfl_xor(ss, 16);
        ss += __shfl_xor(ss, 32);
        const float rstd = rsqrtf(ss * (1.0f / 64.0f) + 1e-6f);
#pragma unroll
        for (int j = 0; j < 4; ++j)
#pragma unroll
          for (int e = 0; e < 4; ++e) v[j][e] *= rstd * gain[j * 16 + quad * 4 + e];
        if (kidx >= 256) {
          const int t = kidx - 256, pr = t >> 6, pc = t & 63;
#pragma unroll
          for (int e = 0; e < 4; ++e) {
            const int f = quad * 4 + e;
            const float cr = rope[(pr * 16 + f) * 2], sr = rope[(pr * 16 + f) * 2 + 1];
            const float cc = rope[(pc * 16 + f) * 2], sc = rope[(pc * 16 + f) * 2 + 1];
            float x1 = v[0][e], x2 = v[1][e];
            v[0][e] = x1 * cr - x2 * sr;
            v[1][e] = x2 * cr + x1 * sr;
            x1 = v[2][e]; x2 = v[3][e];
            v[2][e] = x1 * cc - x2 * sc;
            v[3][e] = x2 * cc + x1 * sc;
          }
        }
        if (isq) {
#pragma unroll
          for (int j = 0; j < 4; ++j)
#pragma unroll
            for (int e = 0; e < 4; ++e) v[j][e] *= 0.125f * LOG2E;
        }
      }
      if (kind == 2) {
#pragma unroll
        for (int j = 0; j < 4; ++j)
#pragma unroll
          for (int e = 0; e < 4; ++e) {
            const int c = (cb - 16) * 64 + j * 16 + quad * 4 + e;
            AVT[((size_t)(b * 4 + (c >> 7)) * 128 + (c & 127)) * TPB + kidx] = f2bf(v[j][e]);
          }
      } else if (kind == 5) {
#pragma unroll
        for (int j = 0; j < 4; ++j)
#pragma unroll
          for (int e = 0; e < 4; ++e) {
            const int d = j * 16 + quad * 4 + e;
            BVT[((size_t)(b * 2 + (cb - 34)) * 64 + d) * TPB + kidx] = f2bf(v[j][e]);
          }
      } else {
        bf16_t* dst;
        if (kind == 0) dst = AQ + (size_t)row * 512 + cb * 64;
        else if (kind == 1) dst = AK + (size_t)row * 512 + (cb - 8) * 64;
        else if (kind == 3) dst = BQ + (size_t)row * 512 + (cb - 24) * 64;
        else dst = BK + (size_t)row * 128 + (cb - 32) * 64;
#pragma unroll
        for (int j = 0; j < 4; ++j) {
          uint2 w;
          w.x = pack2(v[j][0], v[j][1]);
          w.y = pack2(v[j][2], v[j][3]);
          *(uint2*)(dst + j * 16 + quad * 4) = w;
        }
      }
    }
  }
};

struct EpiIn1 {
  const float *c_qn, *c_kn;
  bf16_t *CQ, *CK, *CVT, *RAW;
  float* LORA;
  __device__ __forceinline__ void operator()(const f32x4 (&acc)[4][4], int row0w, int col0w, int l15, int quad) const {
    const int cb = col0w >> 6;
#pragma unroll
    for (int i = 0; i < 4; ++i) {
      const int row = row0w + i * 16 + l15;
      const int b = row / TPB, kidx = row - b * TPB;
      float v[4][4];
#pragma unroll
      for (int j = 0; j < 4; ++j)
#pragma unroll
        for (int e = 0; e < 4; ++e) v[j][e] = acc[i][j][e];
      if (cb < 16) {
        const float* gain = cb < 8 ? c_qn : c_kn;
        float ss = 0.f;
#pragma unroll
        for (int j = 0; j < 4; ++j)
#pragma unroll
          for (int e = 0; e < 4; ++e) ss += v[j][e] * v[j][e];
        ss += __shfl_xor(ss, 16);
        ss += __shfl_xor(ss, 32);
        const float rstd = rsqrtf(ss * (1.0f / 64.0f) + 1e-6f) * (cb < 8 ? 0.125f * LOG2E : 1.0f);
        bf16_t* dst = (cb < 8 ? CQ + (size_t)row * 512 + cb * 64 : CK + (size_t)row * 512 + (cb - 8) * 64);
#pragma unroll
        for (int j = 0; j < 4; ++j) {
          const float* gp = gain + j * 16 + quad * 4;
          uint2 w;
          w.x = pack2(v[j][0] * rstd * gp[0], v[j][1] * rstd * gp[1]);
          w.y = pack2(v[j][2] * rstd * gp[2], v[j][3] * rstd * gp[3]);
          *(uint2*)(dst + j * 16 + quad * 4) = w;
        }
      } else if (cb < 24) {
#pragma unroll
        for (int j = 0; j < 4; ++j)
#pragma unroll
          for (int e = 0; e < 4; ++e) {
            const int d = j * 16 + quad * 4 + e;
            CVT[((size_t)(b * 8 + (cb - 16)) * 64 + d) * TPB + kidx] = f2bf(v[j][e]);
          }
      } else if (cb < 48) {
        bf16_t* dst = RAW + (size_t)row * 1536 + (cb - 24) * 64;
#pragma unroll
        for (int j = 0; j < 4; ++j) {
          uint2 w;
          w.x = pack2(v[j][0], v[j][1]);
          w.y = pack2(v[j][2], v[j][3]);
          *(uint2*)(dst + j * 16 + quad * 4) = w;
        }
      } else {
#pragma unroll
        for (int j = 0; j < 4; ++j) {
          const int c = (cb - 48) * 64 + j * 16 + quad * 4;
          if (c < 224) *(float4*)(LORA + (size_t)row * 224 + c) = make_float4(v[j][0], v[j][1], v[j][2], v[j][3]);
        }
      }
    }
  }
};

struct EpiRes {
  const float *lat_src, *ctx_src;
  float *lat_dst, *ctx_dst;
  const float* gate;
  __device__ __forceinline__ void operator()(const f32x4 (&acc)[4][4], int row0w, int col0w, int l15, int quad) const {
#pragma unroll
    for (int i = 0; i < 4; ++i) {
      const int row = row0w + i * 16 + l15;
      const int b = row / TPB, kidx = row - b * TPB;
      const bool isc = kidx < 256;
      const size_t off = isc ? (size_t)(b * 256 + kidx) * DM : (size_t)(b * 16384 + kidx - 256) * DM;
      const float* src = (isc ? ctx_src : lat_src) + off;
      float* dst = (isc ? ctx_dst : lat_dst) + off;
      const float* g = gate + (isc ? 2 : b) * 6144;
#pragma unroll
      for (int j = 0; j < 4; ++j) {
        const int n = col0w + j * 16 + quad * 4;
        const float4 xo = *(const float4*)(src + n);
        const float4 g4 = *(const float4*)(g + n);
        float4 o;
        o.x = xo.x + g4.x * acc[i][j][0];
        o.y = xo.y + g4.y * acc[i][j][1];
        o.z = xo.z + g4.z * acc[i][j][2];
        o.w = xo.w + g4.w * acc[i][j][3];
        *(float4*)(dst + n) = o;
      }
    }
  }
};

struct EpiGU {
  bf16_t* ACT;
  __device__ __forceinline__ void operator()(const f32x4 (&acc)[4][4], int row0w, int col0w, int l15, int quad) const {
    const int chunk = col0w >> 6;
#pragma unroll
    for (int i = 0; i < 4; ++i) {
      const int row = row0w + i * 16 + l15;
#pragma unroll
      for (int j = 0; j < 2; ++j) {
        float r[4];
#pragma unroll
        for (int e = 0; e < 4; ++e) {
          const float g = acc[i][j][e], u = acc[i][j + 2][e];
          r[e] = g * sigmoidf_(g) * u;
        }
        uint2 w;
        w.x = pack2(r[0], r[1]);
        w.y = pack2(r[2], r[3]);
        *(uint2*)(ACT + (size_t)row * DFF + chunk * 32 + j * 16 + quad * 4) = w;
      }
    }
  }
};

template <int NMAP, int NDT, int MODE, bool FIXED>
__device__ __forceinline__ void attn_unit(const bf16_t* __restrict__ Qp, int ldq, const bf16_t* __restrict__ Kp, int ldk,
                                          const bf16_t* __restrict__ Vtp, int seg_lo, int nseg, int qk0,
                                          const float* s_rpb, int na_i, int na_r0, float negM,
                                          f32x4 (&o)[NMAP][NDT], float (&m)[NMAP], float (&l)[NMAP], char* smem) {
  bf16_t* sK = (bf16_t*)smem;
  bf16_t* sVt = sK + NMAP * 64 * LSTR;
  int tid = threadIdx.x;
  asm volatile("" : "+v"(tid));
  const int lane = tid & 63, wave = tid >> 6;
  const int l15 = lane & 15, quad = lane >> 4;
  bf16x8 qf[NMAP][2];
  {
    const bf16_t* qrow = Qp + (size_t)(wave * 16 + l15) * ldq;
#pragma unroll
    for (int c = 0; c < NMAP; ++c)
#pragma unroll
      for (int ks = 0; ks < 2; ++ks) qf[c][ks] = *(const bf16x8*)(qrow + c * 64 + ks * 32 + quad * 8);
  }
#pragma unroll
  for (int c = 0; c < NMAP; ++c) {
    m[c] = -1e30f;
    l[c] = 0.f;
#pragma unroll
    for (int dt = 0; dt < NDT; ++dt) o[c][dt] = (f32x4){0.f, 0.f, 0.f, 0.f};
  }
  const int ntiles = 4 + nseg;
  constexpr int NVL = NDT / 2;
  uint4 rk00, rk01, rk10, rk11, rv0, rv1, rv2, rv3;
  rk10 = rk11 = rv2 = rv3 = make_uint4(0, 0, 0, 0);
  const int lr = tid >> 3, lch = (tid & 7) * 8;
  const uint32_t koff0 = (uint32_t)(lr * ldk + lch) * 2u, koff1 = (uint32_t)((lr + 32) * ldk + lch) * 2u;
  const uint32_t voff0 = (uint32_t)(lr * TPB + lch) * 2u, voff1 = (uint32_t)((lr + 32) * TPB + lch) * 2u,
                 voff2 = (uint32_t)((lr + 64) * TPB + lch) * 2u, voff3 = (uint32_t)((lr + 96) * TPB + lch) * 2u;
#define ATTN_LOAD_K(k0_)                                              \
  {                                                                   \
    const char* kb = (const char*)(Kp + (size_t)(k0_) * ldk);         \
    rk00 = *(const uint4*)(kb + koff0);                               \
    rk01 = *(const uint4*)(kb + koff1);                               \
    if (NMAP > 1) {                                                   \
      rk10 = *(const uint4*)(kb + 128 + koff0);                       \
      rk11 = *(const uint4*)(kb + 128 + koff1);                       \
    }                                                                 \
  }
#define ATTN_LOAD_V(k0_)                                              \
  {                                                                   \
    const char* vb = (const char*)(Vtp + (k0_));                      \
    rv0 = *(const uint4*)(vb + voff0);                                \
    rv1 = *(const uint4*)(vb + voff1);                                \
    if (NVL > 2) {                                                    \
      rv2 = *(const uint4*)(vb + voff2);                              \
      rv3 = *(const uint4*)(vb + voff3);                              \
    }                                                                 \
  }
  ATTN_LOAD_K(0)
  ATTN_LOAD_V(0)
  for (int n = 0; n < ntiles; ++n) {
    const int kidx0 = (MODE == 0) ? n * 64 : (n < 4 ? n * 64 : seg_lo + (n - 4) * 64);
    __syncthreads();
    *(uint4*)(sK + (lr) * LSTR + lch) = rk00;
    *(uint4*)(sK + (lr + 32) * LSTR + lch) = rk01;
    if (NMAP > 1) {
      *(uint4*)(sK + (64 + lr) * LSTR + lch) = rk10;
      *(uint4*)(sK + (64 + lr + 32) * LSTR + lch) = rk11;
    }
    *(uint4*)(sVt + (lr) * LSTR + lch) = rv0;
    *(uint4*)(sVt + (lr + 32) * LSTR + lch) = rv1;
    if (NVL > 2) {
      *(uint4*)(sVt + (lr + 64) * LSTR + lch) = rv2;
      *(uint4*)(sVt + (lr + 96) * LSTR + lch) = rv3;
    }
    __syncthreads();
    const int knext = (MODE == 0) ? (n + 1) * 64 : ((n + 1) < 4 ? (n + 1) * 64 : seg_lo + (n + 1 - 4) * 64);
    if (n + 1 < ntiles) {
      ATTN_LOAD_K(knext)
    }
    bf16x8 pf[NMAP][2];
#pragma unroll
    for (int c = 0; c < NMAP; ++c) {
      f32x4 s[4];
#pragma unroll
      for (int kt = 0; kt < 4; ++kt) {
        const float ini = FIXED ? negM : 0.f;
        s[kt] = (f32x4){ini, ini, ini, ini};
        const int krow = 32 * (kt >> 1) + (l15 >> 2) * 8 + (kt & 1) * 4 + (l15 & 3);
#pragma unroll
        for (int ks = 0; ks < 2; ++ks) {
          const bf16x8 kf = *(const bf16x8*)(sK + (c * 64 + krow) * LSTR + ks * 32 + quad * 8);
          s[kt] = __builtin_amdgcn_mfma_f32_16x16x32_bf16(kf, qf[c][ks], s[kt], 0, 0, 0);
        }
      }
      if (MODE == 1 && n >= 4) {
        const int kp0 = kidx0 - 256, qp = qk0 - 256 + wave * 16 + l15;
#pragma unroll
        for (int kt = 0; kt < 4; ++kt)
#pragma unroll
          for (int e = 0; e < 4; ++e) {
            const int d = qp - (kp0 + 32 * (kt >> 1) + quad * 8 + (kt & 1) * 4 + e);
            if (d > 128 || d < -128) s[kt][e] = -1e30f;
          }
      }
      if (MODE == 2 && n >= 4) {
        const int ri = na_r0 + (n - 4) - na_i + 7;
        const int qc = wave * 16 + l15;
        const int cs = min(max(qc - 8, 0), 48);
#pragma unroll
        for (int kt = 0; kt < 4; ++kt)
#pragma unroll
          for (int e = 0; e < 4; ++e) {
            const int kc = 32 * (kt >> 1) + quad * 8 + (kt & 1) * 4 + e;
            if (kc >= cs && kc < cs + 16) s[kt][e] += s_rpb[ri * 31 + kc - qc + 15];
            else s[kt][e] = -1e30f;
          }
      }
      if (FIXED) {
        float ls = 0.f;
#pragma unroll
        for (int kt = 0; kt < 4; ++kt)
#pragma unroll
          for (int e = 0; e < 4; ++e) {
            s[kt][e] = fexp2(s[kt][e]);
            ls += s[kt][e];
          }
        l[c] += ls;
      } else {
        float mx = s[0][0];
#pragma unroll
        for (int kt = 0; kt < 4; ++kt)
#pragma unroll
          for (int e = 0; e < 4; ++e) mx = fmaxf(mx, s[kt][e]);
        mx = fmaxf(mx, __shfl_xor(mx, 16));
        mx = fmaxf(mx, __shfl_xor(mx, 32));
        const float mnew = fmaxf(m[c], mx);
        const float alpha = fexp2(m[c] - mnew);
        m[c] = mnew;
        float ls = 0.f;
#pragma unroll
        for (int kt = 0; kt < 4; ++kt)
#pragma unroll
          for (int e = 0; e < 4; ++e) {
            s[kt][e] = fexp2(s[kt][e] - mnew);
            ls += s[kt][e];
          }
        l[c] = l[c] * alpha + ls;
        if (__ballot(alpha != 1.0f) != 0ull) {
#pragma unroll
          for (int dt = 0; dt < NDT; ++dt) o[c][dt] *= alpha;
        }
      }
      __builtin_amdgcn_sched_barrier(0);
#pragma unroll
      for (int ks2 = 0; ks2 < 2; ++ks2) {
        union { uint32_t u[4]; bf16x8 v; } pk;
        pk.u[0] = pack2(s[2 * ks2][0], s[2 * ks2][1]);
        pk.u[1] = pack2(s[2 * ks2][2], s[2 * ks2][3]);
        pk.u[2] = pack2(s[2 * ks2 + 1][0], s[2 * ks2 + 1][1]);
        pk.u[3] = pack2(s[2 * ks2 + 1][2], s[2 * ks2 + 1][3]);
        pf[c][ks2] = pk.v;
      }
    }
    if (n + 1 < ntiles) {
      ATTN_LOAD_V(knext)
    }
#pragma unroll
    for (int ks2 = 0; ks2 < 2; ++ks2) {
      __builtin_amdgcn_sched_barrier(0);
#pragma unroll
      for (int dt = 0; dt < NDT; ++dt) {
        const bf16x8 vf = *(const bf16x8*)(sVt + (dt * 16 + l15) * LSTR + 32 * ks2 + quad * 8);
#pragma unroll
        for (int c = 0; c < NMAP; ++c) o[c][dt] = __builtin_amdgcn_mfma_f32_16x16x32_bf16(vf, pf[c][ks2], o[c][dt], 0, 0, 0);
      }
    }
  }
#pragma unroll
  for (int c = 0; c < NMAP; ++c) {
    l[c] += __shfl_xor(l[c], 16);
    l[c] += __shfl_xor(l[c], 32);
  }
}

__device__ __forceinline__ void attn_diff32(const bf16_t* __restrict__ Qp, const bf16_t* __restrict__ Kp,
                                            const bf16_t* __restrict__ Vtp, int ntiles, float negM,
                                            f32x4 (&o)[2][8], float (&l)[2], char* smem) {
  bf16_t* sK = (bf16_t*)smem;
  bf16_t* sVt = sK + 2 * 64 * LSTR;
  int tid = threadIdx.x;
  asm volatile("" : "+v"(tid));
  const int lane = tid & 63, wave = tid >> 6;
  const int l15 = lane & 15, quad = lane >> 4;
  const int cmap = wave >> 1, qg = wave & 1;
  bf16x8 qf[2][2];
#pragma unroll
  for (int qt = 0; qt < 2; ++qt) {
    const bf16_t* qrow = Qp + (size_t)(qg * 32 + qt * 16 + l15) * 512 + cmap * 64;
#pragma unroll
    for (int ks = 0; ks < 2; ++ks) qf[qt][ks] = *(const bf16x8*)(qrow + ks * 32 + quad * 8);
  }
#pragma unroll
  for (int qt = 0; qt < 2; ++qt) {
    l[qt] = 0.f;
#pragma unroll
    for (int dt = 0; dt < 8; ++dt) o[qt][dt] = (f32x4){0.f, 0.f, 0.f, 0.f};
  }
  uint4 rk00, rk01, rk10, rk11, rv0, rv1, rv2, rv3;
  const int lr = tid >> 3, lch = (tid & 7) * 8;
  const uint32_t koff0 = (uint32_t)(lr * 512 + lch) * 2u, koff1 = (uint32_t)((lr + 32) * 512 + lch) * 2u;
  const uint32_t voff0 = (uint32_t)(lr * TPB + lch) * 2u, voff1 = (uint32_t)((lr + 32) * TPB + lch) * 2u,
                 voff2 = (uint32_t)((lr + 64) * TPB + lch) * 2u, voff3 = (uint32_t)((lr + 96) * TPB + lch) * 2u;
#define AD_LOAD_K(k0_)                                                \
  {                                                                   \
    const char* kb = (const char*)(Kp + (size_t)(k0_) * 512);         \
    rk00 = *(const uint4*)(kb + koff0);                               \
    rk01 = *(const uint4*)(kb + koff1);                               \
    rk10 = *(const uint4*)(kb + 128 + koff0);                         \
    rk11 = *(const uint4*)(kb + 128 + koff1);                         \
  }
#define AD_LOAD_V(k0_)                                                \
  {                                                                   \
    const char* vb = (const char*)(Vtp + (k0_));                      \
    rv0 = *(const uint4*)(vb + voff0);                                \
    rv1 = *(const uint4*)(vb + voff1);                                \
    rv2 = *(const uint4*)(vb + voff2);                                \
    rv3 = *(const uint4*)(vb + voff3);                                \
  }
  AD_LOAD_K(0)
  AD_LOAD_V(0)
  const bf16_t* sKc = sK + cmap * 64 * LSTR;
  for (int n = 0; n < ntiles; ++n) {
    __syncthreads();
    *(uint4*)(sK + (lr) * LSTR + lch) = rk00;
    *(uint4*)(sK + (lr + 32) * LSTR + lch) = rk01;
    *(uint4*)(sK + (64 + lr) * LSTR + lch) = rk10;
    *(uint4*)(sK + (64 + lr + 32) * LSTR + lch) = rk11;
    *(uint4*)(sVt + (lr) * LSTR + lch) = rv0;
    *(uint4*)(sVt + (lr + 32) * LSTR + lch) = rv1;
    *(uint4*)(sVt + (lr + 64) * LSTR + lch) = rv2;
    *(uint4*)(sVt + (lr + 96) * LSTR + lch) = rv3;
    __syncthreads();
    const int knext = (n + 1) * 64;
    if (n + 1 < ntiles) { AD_LOAD_K(knext) }
    f32x4 s[2][4];
    __builtin_amdgcn_s_setprio(1);
#pragma unroll
    for (int kt = 0; kt < 4; ++kt) {
      s[0][kt] = (f32x4){negM, negM, negM, negM};
      s[1][kt] = (f32x4){negM, negM, negM, negM};
      const int krow = 32 * (kt >> 1) + (l15 >> 2) * 8 + (kt & 1) * 4 + (l15 & 3);
#pragma unroll
      for (int ks = 0; ks < 2; ++ks) {
        const bf16x8 kf = *(const bf16x8*)(sKc + krow * LSTR + ks * 32 + quad * 8);
        s[0][kt] = __builtin_amdgcn_mfma_f32_16x16x32_bf16(kf, qf[0][ks], s[0][kt], 0, 0, 0);
        s[1][kt] = __builtin_amdgcn_mfma_f32_16x16x32_bf16(kf, qf[1][ks], s[1][kt], 0, 0, 0);
      }
    }
    __builtin_amdgcn_s_setprio(0);
    bf16x8 pf[2][2];
#pragma unroll
    for (int qt = 0; qt < 2; ++qt) {
      float ls = 0.f;
#pragma unroll
      for (int kt = 0; kt < 4; ++kt)
#pragma unroll
        for (int e = 0; e < 4; ++e) {
          s[qt][kt][e] = fexp2(s[qt][kt][e]);
          ls += s[qt][kt][e];
        }
      l[qt] += ls;
#pragma unroll
      for (int ks2 = 0; ks2 < 2; ++ks2) {
        union { uint32_t u[4]; bf16x8 v; } pk;
        pk.u[0] = pack2(s[qt][2 * ks2][0], s[qt][2 * ks2][1]);
        pk.u[1] = pack2(s[qt][2 * ks2][2], s[qt][2 * ks2][3]);
        pk.u[2] = pack2(s[qt][2 * ks2 + 1][0], s[qt][2 * ks2 + 1][1]);
        pk.u[3] = pack2(s[qt][2 * ks2 + 1][2], s[qt][2 * ks2 + 1][3]);
        pf[qt][ks2] = pk.v;
      }
    }
    if (n + 1 < ntiles) { AD_LOAD_V(knext) }
    __builtin_amdgcn_s_setprio(1);
#pragma unroll
    for (int ks2 = 0; ks2 < 2; ++ks2)
#pragma unroll
      for (int dt = 0; dt < 8; ++dt) {
        const bf16x8 vf = *(const bf16x8*)(sVt + (dt * 16 + l15) * LSTR + 32 * ks2 + quad * 8);
        o[0][dt] = __builtin_amdgcn_mfma_f32_16x16x32_bf16(vf, pf[0][ks2], o[0][dt], 0, 0, 0);
        o[1][dt] = __builtin_amdgcn_mfma_f32_16x16x32_bf16(vf, pf[1][ks2], o[1][dt], 0, 0, 0);
      }
    __builtin_amdgcn_s_setprio(0);
  }
#pragma unroll
  for (int qt = 0; qt < 2; ++qt) {
    l[qt] += __shfl_xor(l[qt], 16);
    l[qt] += __shfl_xor(l[qt], 32);
  }
}

__device__ __forceinline__ void phase_attn0(const Params& P, char* smem) {
  char* ws = P.ws;
  const bf16_t* AQ = (const bf16_t*)(ws + OFF_AQ);
  const bf16_t* AK = (const bf16_t*)(ws + OFF_AK);
  const bf16_t* AVT = (const bf16_t*)(ws + OFF_AVT);
  const bf16_t* BQ = (const bf16_t*)(ws + OFF_BQ);
  const bf16_t* BK = (const bf16_t*)(ws + OFF_BK);
  const bf16_t* BVT = (const bf16_t*)(ws + OFF_BVT);
  bf16_t* Acat = (bf16_t*)(ws + OFF_A);
  const float lam = ((const float*)(ws + OFF_LAM))[0];
  const float negM = -((const float*)(ws + OFF_LAM))[1];
  const bool fixed_ok = ((const float*)(ws + OFF_LAM))[1] < 60.0f;
  const float lambda_init = 0.2f;
  const int lane = threadIdx.x & 63, wave = threadIdx.x >> 6, l15 = lane & 15, quad = lane >> 4;
  for (int u = blockIdx.x; u < 2080; u += gridDim.x) {
    int b, head, qb;
    if (u < 2048) {
      const int bh = u & 7;
      b = bh >> 2; head = bh & 3; qb = 4 + (u >> 3);
    }
    else { const int cu = u - 2048; b = cu >> 4; head = (cu >> 2) & 3; qb = cu & 3; }
    const int qk0 = qb * 64;
    const int nseg = qb >= 4 ? 256 : 0;
    f32x4 o[2][8];
    float m[2], l[2];
    if (fixed_ok) {
      f32x4 o2[2][8];
      float l2[2];
      attn_diff32(AQ + (size_t)(b * TPB + qk0) * 512 + head * 128, AK + (size_t)(b * TPB) * 512 + head * 128,
                  AVT + (size_t)(b * 4 + head) * 128 * TPB, 4 + nseg, negM, o2, l2, smem);
      float* xch = (float*)smem;
      const int cmap = wave >> 1, qg = wave & 1;
      __syncthreads();
      if (cmap == 1) {
#pragma unroll
        for (int qt = 0; qt < 2; ++qt) {
          const float i1 = lam / l2[qt];
#pragma unroll
          for (int dt = 0; dt < 8; ++dt)
            *(f32x4*)(xch + (size_t)((qg * 32 + qt * 16 + l15) * 128 + dt * 16 + quad * 4)) = o2[qt][dt] * i1;
        }
      }
      __syncthreads();
      if (cmap == 0) {
#pragma unroll
        for (int qt = 0; qt < 2; ++qt) {
          const float i0 = 1.0f / l2[qt];
          float ss = 0.f;
#pragma unroll
          for (int dt = 0; dt < 8; ++dt) {
            const f32x4 other = *(const f32x4*)(xch + (size_t)((qg * 32 + qt * 16 + l15) * 128 + dt * 16 + quad * 4));
            o2[qt][dt] = o2[qt][dt] * i0 - other;
#pragma unroll
            for (int e = 0; e < 4; ++e) ss += o2[qt][dt][e] * o2[qt][dt][e];
          }
          ss += __shfl_xor(ss, 16);
          ss += __shfl_xor(ss, 32);
          const float rstd = rsqrtf(ss * (1.0f / 128.0f) + 1e-6f) * (1.0f - lambda_init);
          const int row = b * TPB + qk0 + qg * 32 + qt * 16 + l15;
          bf16_t* dst = Acat + (size_t)row * DM + head * 128;
#pragma unroll
          for (int dt = 0; dt < 8; ++dt) {
            const float* sg = P.a_subln + dt * 16 + quad * 4;
            uint2 w;
            w.x = pack2(o2[qt][dt][0] * rstd * sg[0], o2[qt][dt][1] * rstd * sg[1]);
            w.y = pack2(o2[qt][dt][2] * rstd * sg[2], o2[qt][dt][3] * rstd * sg[3]);
            *(uint2*)(dst + dt * 16 + quad * 4) = w;
          }
        }
      }
      continue;
    }
    {
      attn_unit<2, 8, 0, false>(AQ + (size_t)(b * TPB + qk0) * 512 + head * 128, 512, AK + (size_t)(b * TPB) * 512 + head * 128, 512,
                                AVT + (size_t)(b * 4 + head) * 128 * TPB, 256, nseg, qk0, nullptr, 0, 0, 0.f, o, m, l, smem);
    }

    const float i0 = 1.0f / l[0], i1 = lam / l[1];
    float ss = 0.f;
#pragma unroll
    for (int dt = 0; dt < 8; ++dt)
#pragma unroll
      for (int e = 0; e < 4; ++e) {
        const float v = o[0][dt][e] * i0 - o[1][dt][e] * i1;
        o[0][dt][e] = v;
        ss += v * v;
      }
    ss += __shfl_xor(ss, 16);
    ss += __shfl_xor(ss, 32);
    const float rstd = rsqrtf(ss * (1.0f / 128.0f) + 1e-6f) * (1.0f - lambda_init);
    const int row = b * TPB + qk0 + wave * 16 + l15;
    bf16_t* dst = Acat + (size_t)row * DM + head * 128;
#pragma unroll
    for (int dt = 0; dt < 8; ++dt) {
      const float* sg = P.a_subln + dt * 16 + quad * 4;
      uint2 w;
      w.x = pack2(o[0][dt][0] * rstd * sg[0], o[0][dt][1] * rstd * sg[1]);
      w.y = pack2(o[0][dt][2] * rstd * sg[2], o[0][dt][3] * rstd * sg[3]);
      *(uint2*)(dst + dt * 16 + quad * 4) = w;
    }
  }
  for (int u = blockIdx.x; u < 4160; u += gridDim.x) {
    const int b = u / 2080, r = u - b * 2080, qh = r / 260, qb = r - qh * 260;
    const int g = qh >> 2;
    const int qk0 = qb * 64;
    int seg_lo = 256, nseg = 0;
    if (qb >= 4) {
      int lo = qk0 - 128, hi = qk0 + 128;
      if (lo < 256) lo = 256;
      if (hi > TPB - 64) hi = TPB - 64;
      seg_lo = lo;
      nseg = (hi - lo) / 64 + 1;
    }
    f32x4 o[1][4];
    float m[1], l[1];
    attn_unit<1, 4, 1, false>(BQ + (size_t)(b * TPB + qk0) * 512 + qh * 64, 512, BK + (size_t)(b * TPB) * 128 + g * 64, 128,
                              BVT + (size_t)(b * 2 + g) * 64 * TPB, seg_lo, nseg, qk0, nullptr, 0, 0, 0.f, o, m, l, smem);
    const float lt = l[0] + fexp2(P.b_sink[qh] * LOG2E - m[0]);
    const float inv = 1.0f / lt;
    const int row = b * TPB + qk0 + wave * 16 + l15;
    bf16_t* dst = Acat + (size_t)row * DM + 512 + qh * 64;
#pragma unroll
    for (int dt = 0; dt < 4; ++dt) {
      uint2 w;
      w.x = pack2(o[0][dt][0] * inv, o[0][dt][1] * inv);
      w.y = pack2(o[0][dt][2] * inv, o[0][dt][3] * inv);
      *(uint2*)(dst + dt * 16 + quad * 4) = w;
    }
  }
}

__device__ __forceinline__ void phase_na(const Params& P, char* smem) {
  char* ws = P.ws;
  const bf16_t* CQ = (const bf16_t*)(ws + OFF_CQ);
  const bf16_t* CK = (const bf16_t*)(ws + OFF_CK);
  const bf16_t* CVT = (const bf16_t*)(ws + OFF_CVT);
  bf16_t* Acat = (bf16_t*)(ws + OFF_A);
  float* s_rpb = (float*)(smem + 40960);
  const int lane = threadIdx.x & 63, wave = threadIdx.x >> 6, l15 = lane & 15, quad = lane >> 4;
  for (int u = blockIdx.x; u < 4096; u += gridDim.x) {
    const int b = u >> 11, h = (u >> 8) & 7, gi = u & 255;
    const int r0 = min(max(gi - 4, 0), 248);
    __syncthreads();
    for (int e = threadIdx.x; e < 465; e += 256) s_rpb[e] = P.c_rpb[h * 465 + e] * LOG2E;
    __syncthreads();
    const int qk0 = 256 + gi * 64;
    f32x4 o[1][4];
    float m[1], l[1];
    attn_unit<1, 4, 2, false>(CQ + (size_t)(b * TPB + qk0) * 512 + h * 64, 512, CK + (size_t)(b * TPB) * 512 + h * 64, 512,
                              CVT + (size_t)(b * 8 + h) * 64 * TPB, 256 + r0 * 64, 8, qk0, s_rpb, gi, r0, 0.f, o, m, l, smem);
    const float inv = 1.0f / l[0];
    const int row = b * TPB + qk0 + wave * 16 + l15;
    bf16_t* dst = Acat + (size_t)row * DM + h * 64;
#pragma unroll
    for (int dt = 0; dt < 4; ++dt) {
      uint2 w;
      w.x = pack2(o[0][dt][0] * inv, o[0][dt][1] * inv);
      w.y = pack2(o[0][dt][2] * inv, o[0][dt][3] * inv);
      *(uint2*)(dst + dt * 16 + quad * 4) = w;
    }
  }
}

__device__ __forceinline__ void phase_norm(const float* lat_src, const float* ctx_src, const float* gain, const float* modl,
                                           int sh_off, int sc_off, bf16_t* A, bool lat_only) {
  const int lane = threadIdx.x & 63, wave = threadIdx.x >> 6;
  const int total = lat_only ? 32768 : MROWS;
  for (int idx0 = (blockIdx.x * 4 + wave) * 2; idx0 < total; idx0 += gridDim.x * 8) {
    float4 xv[2][4];
    const float* md[2];
    int rowi[2];
#pragma unroll
    for (int u = 0; u < 2; ++u) {
      const int idx = idx0 + u;
      const int row = lat_only ? ((idx >> 14) * TPB + 256 + (idx & 16383)) : idx;
      const int b = row / TPB, kidx = row - b * TPB;
      const bool isc = kidx < 256;
      const float* src = isc ? ctx_src + (size_t)(b * 256 + kidx) * DM : lat_src + (size_t)(b * 16384 + kidx - 256) * DM;
      md[u] = modl + (isc ? 2 : b) * 6144;
      rowi[u] = row;
#pragma unroll
      for (int i = 0; i < 4; ++i) xv[u][i] = *(const float4*)(src + i * 256 + lane * 4);
    }
#pragma unroll
    for (int u = 0; u < 2; ++u) {
      float ss = 0.f;
#pragma unroll
      for (int i = 0; i < 4; ++i) ss += xv[u][i].x * xv[u][i].x + xv[u][i].y * xv[u][i].y + xv[u][i].z * xv[u][i].z + xv[u][i].w * xv[u][i].w;
      ss = wave_sum(ss);
      const float rstd = rsqrtf(ss * (1.0f / 1024.0f) + 1e-6f);
#pragma unroll
      for (int i = 0; i < 4; ++i) {
        const int c = i * 256 + lane * 4;
        const float4 g = *(const float4*)(gain + c);
        const float4 sh = *(const float4*)(md[u] + sh_off + c);
        const float4 sc = *(const float4*)(md[u] + sc_off + c);
        uint2 w;
        w.x = pack2(xv[u][i].x * rstd * g.x * (1.f + sc.x) + sh.x, xv[u][i].y * rstd * g.y * (1.f + sc.y) + sh.y);
        w.y = pack2(xv[u][i].z * rstd * g.z * (1.f + sc.z) + sh.z, xv[u][i].w * rstd * g.w * (1.f + sc.w) + sh.w);
        *(uint2*)(A + (size_t)rowi[u] * DM + c) = w;
      }
    }
  }
}

__device__ __forceinline__ void conv_tile(const float* __restrict__ W, int K, int N, int Npad, bf16_t* __restrict__ dst, int mode,
                          int kt, int nt, char* smem) {
  float* T = (float*)smem;
  const int tid = threadIdx.x;
  const int k0 = kt * 64, n0 = nt * 64;
  __syncthreads();
  {
    const int r = tid >> 4, c4 = (tid & 15) * 4;
#pragma unroll
    for (int i = 0; i < 4; ++i) {
      const int k = r + 16 * i, n = n0 + c4;
      float4 v = make_float4(0.f, 0.f, 0.f, 0.f);
      if (n < N) v = *(const float4*)(W + (size_t)(k0 + k) * N + n);
      T[k * 65 + c4 + 0] = v.x;
      T[k * 65 + c4 + 1] = v.y;
      T[k * 65 + c4 + 2] = v.z;
      T[k * 65 + c4 + 3] = v.w;
    }
  }
  __syncthreads();
  {
    const int n = tid >> 2, ks = (tid & 3) * 16;
    const int gn = n0 + n;
    if (gn < Npad) {
      const int drow = mode == 0 ? gn : ((gn >> 5) * 64 + (gn & 31) + (mode == 2 ? 32 : 0));
      uint32_t w[8];
#pragma unroll
      for (int q = 0; q < 8; ++q) w[q] = pack2(T[(ks + 2 * q) * 65 + n], T[(ks + 2 * q + 1) * 65 + n]);
      uint4* d = (uint4*)(dst + (size_t)drow * K + k0 + ks);
      d[0] = make_uint4(w[0], w[1], w[2], w[3]);
      d[1] = make_uint4(w[4], w[5], w[6], w[7]);
    }
  }
}

__device__ __forceinline__ void phase_conv(const Params& P, int layer, char* smem, int part, int rank, int nrank) {
  char* ws = P.ws;
  const float* w_in = layer == 0 ? P.ab_w_in : P.cd_w_in;
  const int n_in = layer == 0 ? 2304 : 3296;
  const int np_in = layer == 0 ? 2304 : 3328;
  const int nt_in = np_in / 64;
  const float* w_out = layer == 0 ? P.ab_w_out : P.cd_w_out;
  const int t_in = 16 * nt_in;
  const int t_lo = part == 2 ? t_in : 0;
  const int total = part == 1 ? t_in : t_in + 256 + 3 * 704;
  for (int t = t_lo + rank; t < total; t += nrank) {
    if (t < t_in) {
      conv_tile(w_in, 1024, n_in, np_in, (bf16_t*)(ws + OFF_WIN), 0, t / nt_in, t % nt_in, smem);
    } else if (t < t_in + 256) {
      const int q = t - t_in;
      conv_tile(w_out, 1024, 1024, 1024, (bf16_t*)(ws + OFF_WOUT), 0, q >> 4, q & 15, smem);
    } else if (t < t_in + 256 + 704) {
      const int q = t - t_in - 256;
      conv_tile(P.w_gate + (size_t)layer * 1024 * DFF, 1024, DFF, DFF, (bf16_t*)(ws + OFF_WGU), 1, q / 44, q % 44, smem);
    } else if (t < t_in + 256 + 1408) {
      const int q = t - t_in - 256 - 704;
      conv_tile(P.w_up + (size_t)layer * 1024 * DFF, 1024, DFF, DFF, (bf16_t*)(ws + OFF_WGU), 2, q / 44, q % 44, smem);
    } else {
      const int q = t - t_in - 256 - 1408;
      conv_tile(P.w_down + (size_t)layer * DFF * 1024, DFF, 1024, 1024, (bf16_t*)(ws + OFF_WDN), 0, q >> 4, q & 15, smem);
    }
  }
}

__device__ __forceinline__ void phase_adaln(const Params& P, char* smem) {
  float* sc = (float*)smem;
  float* red = sc + 3 * 1024;
  float* mod = (float*)(P.ws + OFF_MOD);
  const int tid = threadIdx.x;
  for (int it = (int)gridDim.x - 1 - (int)blockIdx.x; it < 384; it += gridDim.x) {
    const int layer = it / 192, n0 = (it % 192) * 32;
    __syncthreads();
    for (int e = tid; e < 3072; e += 256) {
      const int i = e >> 10, k = e & 1023;
      const float v = i < 2 ? P.c[i * 1024 + k] : P.c_ctx[k];
      sc[e] = v / (1.0f + __expf(-v));
    }
    __syncthreads();
    const int kg = tid >> 5, col = tid & 31;
    const float* w = P.ada_w + (size_t)layer * 1024 * 6144 + n0 + col;
    float a0 = 0.f, a1 = 0.f, a2 = 0.f;
#pragma unroll 16
    for (int k = kg * 128; k < kg * 128 + 128; ++k) {
      const float wv = w[(size_t)k * 6144];
      a0 += sc[k] * wv;
      a1 += sc[1024 + k] * wv;
      a2 += sc[2048 + k] * wv;
    }
    red[(kg * 32 + col) * 3 + 0] = a0;
    red[(kg * 32 + col) * 3 + 1] = a1;
    red[(kg * 32 + col) * 3 + 2] = a2;
    __syncthreads();
    if (tid < 96) {
      const int i = tid >> 5, cl = tid & 31;
      float sacc = P.ada_b[layer * 6144 + n0 + cl];
#pragma unroll
      for (int g = 0; g < 8; ++g) sacc += red[(g * 32 + cl) * 3 + i];
      mod[(layer * 3 + i) * 6144 + n0 + cl] = sacc;
    }
  }
  if (blockIdx.x == gridDim.x - 1) {
    float* rope = (float*)(P.ws + OFF_ROPE);
    for (int e = tid; e < 4096; e += 256) {
      const int p = e >> 4, f = e & 15;
      const float freq = powf(10000.0f, -(float)(2 * f) / 32.0f);
      const float ang = (float)p * freq;
      rope[e * 2] = cosf(ang);
      rope[e * 2 + 1] = sinf(ang);
    }
    if (tid < 64) {
      float p0 = P.a_lambda[tid] * P.a_lambda[64 + tid];
      float p1 = P.a_lambda[128 + tid] * P.a_lambda[192 + tid];
      p0 = wave_sum(p0);
      p1 = wave_sum(p1);
      float gq = fabsf(P.a_qn[tid]), gk = fabsf(P.a_kn[tid]);
#pragma unroll
      for (int o = 32; o >= 1; o >>= 1) {
        gq = fmaxf(gq, __shfl_xor(gq, o));
        gk = fmaxf(gk, __shfl_xor(gk, o));
      }
      if (tid == 0) {
        ((float*)(P.ws + OFF_LAM))[0] = expf(p0) - expf(p1) + 0.2f;
        ((float*)(P.ws + OFF_LAM))[1] = 8.0f * gq * gk * LOG2E * 1.001f + 0.01f;
      }
    }
  }
}

__device__ __forceinline__ float dppf8(float x, const int sel) {
  const int xi = __float_as_int(x);
  int r;
  if (sel == 0) r = __builtin_amdgcn_update_dpp(0, xi, 0xB1, 0xF, 0xF, true);
  else if (sel == 1) r = __builtin_amdgcn_update_dpp(0, xi, 0x4E, 0xF, 0xF, true);
  else r = __builtin_amdgcn_update_dpp(0, xi, 0x141, 0xF, 0xF, true);
  return __int_as_float(r);
}
__device__ __forceinline__ void phase_lora_conv(const Params& P) {
  bf16_t* WL = (bf16_t*)(P.ws + OFF_WL);
  if (threadIdx.x < 224) {
    const int cl = threadIdx.x / 28, kg = threadIdx.x - cl * 28;
    for (int cb = blockIdx.x; cb < 64; cb += gridDim.x) {
      const int c = cb * 8 + cl;
      float v[8];
#pragma unroll
      for (int q = 0; q < 8; ++q) {
        const int kk = kg * 8 + q;
        if (kk < 64) v[q] = P.d_w2[(size_t)kk * 512 + c];
        else if (kk < 128) v[q] = P.d_a2[(size_t)(kk - 64) * 512 + c];
        else v[q] = P.d_g2[(size_t)(kk - 128) * 512 + c];
      }
      *(uint4*)(WL + (size_t)c * 224 + kg * 8) = make_uint4(pack2(v[0], v[1]), pack2(v[2], v[3]), pack2(v[4], v[5]), pack2(v[6], v[7]));
    }
  }
}

#define PREP_T 32
#define SLS 232
__device__ __forceinline__ void phase_prep(const Params& P, char* smem) {
  char* ws = P.ws;
  bf16_t* sL = (bf16_t*)smem;
  const bf16_t* RAW = (const bf16_t*)(ws + OFF_RAW);
  const float* LORA = (const float*)(ws + OFF_LORA);
  const bf16_t* WL = (const bf16_t*)(ws + OFF_WL);
  bf16_t* XR = (bf16_t*)(ws + OFF_XR);
  bf16_t* XK = (bf16_t*)(ws + OFF_XK);
  bf16_t* XV = (bf16_t*)(ws + OFF_XV);
  bf16_t* KK = (bf16_t*)(ws + OFF_KK);
  bf16_t* DP = (bf16_t*)(ws + OFF_DP);
  bf16_t* AZ = (bf16_t*)(ws + OFF_AZ);
  bf16_t* Acat = (bf16_t*)(ws + OFF_A);
  const float* mu = P.d_mu;
  const int tid = threadIdx.x, lane = tid & 63, wave = tid >> 6, l15 = lane & 15, quad = lane >> 4;
  for (int tt = blockIdx.x; tt < MROWS / PREP_T; tt += gridDim.x) {
    const int row0 = tt * PREP_T;
    const int b = row0 / TPB, k0 = row0 - b * TPB;
    __syncthreads();
    for (int e = tid; e < PREP_T * 8; e += 256) sL[(e >> 3) * SLS + 224 + (e & 7)] = 0;
#pragma unroll 7
    for (int e = tid; e < PREP_T * 224; e += 256) {
      const int tok = e / 224, j = e - tok * 224;
      const int kidx = k0 + tok, row = row0 + tok;
      const bool hp = (kidx != 0 && kidx != 256), hn = (kidx != 255 && kidx != TPB - 1);
      const float x = LORA[(size_t)row * 224 + j];
      const float xp = hp ? LORA[(size_t)(row - 1) * 224 + j] : 0.f;
      const float xn = hn ? LORA[(size_t)(row + 1) * 224 + j] : 0.f;
      const float xs = x + mu[1536 + j] * (0.5f * (xp + xn) - x);
      sL[tok * SLS + j] = f2bf(j < 64 ? (1.0f - 2.0f * __builtin_amdgcn_rcpf(__expf(2.0f * xs) + 1.0f)) : (j < 128 ? xs : sigmoidf_(xs)));
    }
    __syncthreads();
    for (int nt = 0; nt < 8; ++nt) {
      const int n0 = wave * 128 + nt * 16;
      bf16x8 wf[7];
#pragma unroll
      for (int kb = 0; kb < 7; ++kb) wf[kb] = *(const bf16x8*)(WL + (size_t)(n0 + l15) * 224 + kb * 32 + quad * 8);
      const int c4 = n0 + quad * 4;
      const float4 w00 = *(const float4*)(P.d_w0 + c4), w01 = *(const float4*)(P.d_w0 + 512 + c4);
      const float4 a00 = *(const float4*)(P.d_a0 + c4), a01 = *(const float4*)(P.d_a0 + 512 + c4);
#pragma unroll
      for (int mt = 0; mt < PREP_T / 16; ++mt) {
        bf16x8 af[7];
#pragma unroll
        for (int kb = 0; kb < 7; ++kb) af[kb] = *(const bf16x8*)(sL + (mt * 16 + l15) * SLS + kb * 32 + quad * 8);
        const f32x4 zero = (f32x4){0.f, 0.f, 0.f, 0.f};
        f32x4 aw0 = __builtin_amdgcn_mfma_f32_16x16x32_bf16(wf[0], af[0], zero, 0, 0, 0);
        f32x4 aw1 = __builtin_amdgcn_mfma_f32_16x16x32_bf16(wf[1], af[1], zero, 0, 0, 0);
        f32x4 aa0 = __builtin_amdgcn_mfma_f32_16x16x32_bf16(wf[2], af[2], zero, 0, 0, 0);
        f32x4 aa1 = __builtin_amdgcn_mfma_f32_16x16x32_bf16(wf[3], af[3], zero, 0, 0, 0);
        f32x4 ag = __builtin_amdgcn_mfma_f32_16x16x32_bf16(wf[4], af[4], zero, 0, 0, 0);
        ag = __builtin_amdgcn_mfma_f32_16x16x32_bf16(wf[5], af[5], ag, 0, 0, 0);
        ag = __builtin_amdgcn_mfma_f32_16x16x32_bf16(wf[6], af[6], ag, 0, 0, 0);
        const size_t row = (size_t)(row0 + mt * 16 + l15);
        float dp0[4], dp1[4], az0[4], az1[4];
#pragma unroll
        for (int e = 0; e < 4; ++e) {
          const float wb0 = e == 0 ? w00.x : (e == 1 ? w00.y : (e == 2 ? w00.z : w00.w));
          const float wb1 = e == 0 ? w01.x : (e == 1 ? w01.y : (e == 2 ? w01.z : w01.w));
          const float ab0 = e == 0 ? a00.x : (e == 1 ? a00.y : (e == 2 ? a00.z : a00.w));
          const float ab1 = e == 0 ? a01.x : (e == 1 ? a01.y : (e == 2 ? a01.z : a01.w));
#pragma unroll
          for (int z = 0; z < 2; ++z) {
            const float wv = z == 0 ? wb0 + aw0[e] : wb1 + aw1[e];
            const float ee = 0.60653066f * sigmoidf_(wv);
            const float dpv = 1.0f - __expf(-ee);
            const float av = sigmoidf_(z == 0 ? ab0 + aa0[e] : ab1 + aa1[e]);
            if (z == 0) { dp0[e] = dpv; az0[e] = av; } else { dp1[e] = dpv; az1[e] = av; }
          }
        }
        uint2 w;
        w.x = pack2(dp0[0], dp0[1]); w.y = pack2(dp0[2], dp0[3]);
        *(uint2*)(DP + row * 512 + c4) = w;
        w.x = pack2(dp1[0], dp1[1]); w.y = pack2(dp1[2], dp1[3]);
        *(uint2*)(DP + (SZ512 / 2) + row * 512 + c4) = w;
        w.x = pack2(az0[0], az0[1]); w.y = pack2(az0[2], az0[3]);
        *(uint2*)(AZ + row * 512 + c4) = w;
        w.x = pack2(az1[0], az1[1]); w.y = pack2(az1[2], az1[3]);
        *(uint2*)(AZ + (SZ512 / 2) + row * 512 + c4) = w;
        w.x = pack2(ag[0], ag[1]); w.y = pack2(ag[2], ag[3]);
        *(uint2*)(Acat + row * DM + 512 + c4) = w;
      }
    }
    __syncthreads();
    {
      const int c8 = (tid & 63) * 8, tk = tid >> 6;
      float mr[8], mk[8], mv[8], kc[8];
#pragma unroll
      for (int q = 0; q < 8; ++q) { mr[q] = mu[c8 + q]; mk[q] = mu[512 + c8 + q]; mv[q] = mu[1024 + c8 + q]; kc[q] = P.d_k_k[c8 + q]; }
#pragma unroll 2
      for (int pass = 0; pass < PREP_T / 4; ++pass) {
        const int k = pass * 4 + tk;
        const int kidx = k0 + k;
        const size_t row = (size_t)(row0 + k);
        const bool hp = (kidx != 0 && kidx != 256), hn = (kidx != 255 && kidx != TPB - 1);
        uint4 xc[3], xpv[3], xnv[3];
#pragma unroll
        for (int q = 0; q < 3; ++q) {
          xc[q] = *(const uint4*)(RAW + row * 1536 + q * 512 + c8);
          xpv[q] = hp ? *(const uint4*)(RAW + (row - 1) * 1536 + q * 512 + c8) : make_uint4(0u, 0u, 0u, 0u);
          xnv[q] = hn ? *(const uint4*)(RAW + (row + 1) * 1536 + q * 512 + c8) : make_uint4(0u, 0u, 0u, 0u);
        }
        float xs[3][8];
#pragma unroll
        for (int q = 0; q < 3; ++q) {
          const uint32_t cw[4] = {xc[q].x, xc[q].y, xc[q].z, xc[q].w};
          const uint32_t pw[4] = {xpv[q].x, xpv[q].y, xpv[q].z, xpv[q].w};
          const uint32_t nw[4] = {xnv[q].x, xnv[q].y, xnv[q].z, xnv[q].w};
#pragma unroll
          for (int w = 0; w < 4; ++w) {
            const float x0 = __uint_as_float(cw[w] << 16), x1 = __uint_as_float(cw[w] & 0xffff0000u);
            const float p0 = __uint_as_float(pw[w] << 16), p1 = __uint_as_float(pw[w] & 0xffff0000u);
            const float n0 = __uint_as_float(nw[w] << 16), n1 = __uint_as_float(nw[w] & 0xffff0000u);
            const float m0 = q == 0 ? mr[2 * w] : (q == 1 ? mk[2 * w] : mv[2 * w]);
            const float m1 = q == 0 ? mr[2 * w + 1] : (q == 1 ? mk[2 * w + 1] : mv[2 * w + 1]);
            xs[q][2 * w] = x0 + m0 * (0.5f * (p0 + n0) - x0);
            xs[q][2 * w + 1] = x1 + m1 * (0.5f * (p1 + n1) - x1);
          }
        }
        *(uint4*)(XR + row * 512 + c8) = make_uint4(pack2(xs[0][0], xs[0][1]), pack2(xs[0][2], xs[0][3]), pack2(xs[0][4], xs[0][5]), pack2(xs[0][6], xs[0][7]));
        *(uint4*)(XK + row * 512 + c8) = make_uint4(pack2(xs[1][0], xs[1][1]), pack2(xs[1][2], xs[1][3]), pack2(xs[1][4], xs[1][5]), pack2(xs[1][6], xs[1][7]));
        *(uint4*)(XV + row * 512 + c8) = make_uint4(pack2(xs[2][0], xs[2][1]), pack2(xs[2][2], xs[2][3]), pack2(xs[2][4], xs[2][5]), pack2(xs[2][6], xs[2][7]));
        float kv[8], ss = 0.f;
#pragma unroll
        for (int q = 0; q < 8; ++q) { kv[q] = xs[1][q] * kc[q]; ss += kv[q] * kv[q]; }
        ss += dppf8(ss, 0);
        ss += dppf8(ss, 1);
        ss += dppf8(ss, 2);
        const float inv = 1.0f / fmaxf(sqrtf(ss), 1e-12f);
        *(uint4*)(KK + row * 512 + c8) = make_uint4(pack2(kv[0] * inv, kv[1] * inv), pack2(kv[2] * inv, kv[3] * inv),
                                                   pack2(kv[4] * inv, kv[5] * inv), pack2(kv[6] * inv, kv[7] * inv));
      }
    }
  }
}

__device__ __forceinline__ float dppf(float x, const int ctrl_sel) {
  int xi = __float_as_int(x), r;
  if (ctrl_sel == 0) r = __builtin_amdgcn_update_dpp(0, xi, 0xB1, 0xF, 0xF, true);
  else if (ctrl_sel == 1) r = __builtin_amdgcn_update_dpp(0, xi, 0x4E, 0xF, 0xF, true);
  else if (ctrl_sel == 2) r = __builtin_amdgcn_update_dpp(0, xi, 0x141, 0xF, 0xF, true);
  else r = __builtin_amdgcn_update_dpp(0, xi, 0x140, 0xF, 0xF, true);
  return __int_as_float(r);
}
__device__ __forceinline__ float red16(float x) {
  x += dppf(x, 0);
  x += dppf(x, 1);
  x += dppf(x, 2);
  x += dppf(x, 3);
  return x;
}

__device__ __forceinline__ void phase_scan(const Params& P, char* smem) {
  const int kloc = blockIdx.x >> 3;
  if ((kloc & 1) || kloc >= 32) return;
  const int widx = (kloc >> 1) * 8 + (blockIdx.x & 7);
  char* ws = P.ws;
  const int chain = widx >> 2, rg = widx & 3;
  const int z = chain >> 4, b = (chain >> 3) & 1, h = chain & 7;
  const bf16_t* XR = (const bf16_t*)(ws + OFF_XR);
  const bf16_t* XK = (const bf16_t*)(ws + OFF_XK);
  const bf16_t* XV = (const bf16_t*)(ws + OFF_XV);
  const bf16_t* KK = (const bf16_t*)(ws + OFF_KK);
  const bf16_t* DP = (const bf16_t*)(ws + OFF_DP) + (size_t)z * (SZ512 / 2);
  const bf16_t* AZ = (const bf16_t*)(ws + OFF_AZ) + (size_t)z * (SZ512 / 2);
  bf16_t* YZ = (bf16_t*)(ws + OFF_YZ) + (size_t)z * (SZ512 / 2);
  float* buf = (float*)smem;
  const int tid = threadIdx.x;
  const int rowl = tid >> 4, kq = tid & 15;
  const int vrow = rg * 16 + rowl;
  const int sl = tid >> 4, k4 = (tid & 15) * 4;
  float ka[4];
#pragma unroll
  for (int i = 0; i < 4; ++i) ka[i] = P.d_k_a[h * 64 + k4 + i];
  f32x2 S01 = (f32x2){0.f, 0.f}, S23 = (f32x2){0.f, 0.f};
  uint2 g_r[2], g_k[2], g_v[2], g_kk[2], g_dp[2], g_az[2];
  auto kidx_of = [&](int n) { return z == 0 ? n : (n < 256 ? 255 - n : 16895 - n); };
#define SCAN_GLOAD(ci_)                                                              \
  _Pragma("unroll") for (int hh = 0; hh < 2; ++hh) {                                 \
    const int kidx = kidx_of((ci_) * 32 + hh * 16 + sl);                             \
    const size_t off = (size_t)(b * TPB + kidx) * 512 + h * 64 + k4;                 \
    g_r[hh] = *(const uint2*)(XR + off);                                             \
    g_k[hh] = *(const uint2*)(XK + off);                                             \
    g_v[hh] = *(const uint2*)(XV + off);                                             \
    g_kk[hh] = *(const uint2*)(KK + off);                                            \
    g_dp[hh] = *(const uint2*)(DP + off);                                            \
    g_az[hh] = *(const uint2*)(AZ + off);                                            \
  }
  SCAN_GLOAD(0)
  const int nchunks = TPB / 32;
  for (int ci = 0; ci < nchunks; ++ci) {
#pragma unroll
    for (int hh = 0; hh < 2; ++hh) {
      float r[4], k[4], v[4], kk[4], dp[4], az[4];
      r[0] = __uint_as_float(g_r[hh].x << 16); r[1] = __uint_as_float(g_r[hh].x & 0xffff0000u);
      r[2] = __uint_as_float(g_r[hh].y << 16); r[3] = __uint_as_float(g_r[hh].y & 0xffff0000u);
      k[0] = __uint_as_float(g_k[hh].x << 16); k[1] = __uint_as_float(g_k[hh].x & 0xffff0000u);
      k[2] = __uint_as_float(g_k[hh].y << 16); k[3] = __uint_as_float(g_k[hh].y & 0xffff0000u);
      v[0] = __uint_as_float(g_v[hh].x << 16); v[1] = __uint_as_float(g_v[hh].x & 0xffff0000u);
      v[2] = __uint_as_float(g_v[hh].y << 16); v[3] = __uint_as_float(g_v[hh].y & 0xffff0000u);
      kk[0] = __uint_as_float(g_kk[hh].x << 16); kk[1] = __uint_as_float(g_kk[hh].x & 0xffff0000u);
      kk[2] = __uint_as_float(g_kk[hh].y << 16); kk[3] = __uint_as_float(g_kk[hh].y & 0xffff0000u);
      dp[0] = __uint_as_float(g_dp[hh].x << 16); dp[1] = __uint_as_float(g_dp[hh].x & 0xffff0000u);
      dp[2] = __uint_as_float(g_dp[hh].y << 16); dp[3] = __uint_as_float(g_dp[hh].y & 0xffff0000u);
      az[0] = __uint_as_float(g_az[hh].x << 16); az[1] = __uint_as_float(g_az[hh].x & 0xffff0000u);
      az[2] = __uint_as_float(g_az[hh].y << 16); az[3] = __uint_as_float(g_az[hh].y & 0xffff0000u);
      float* bp = buf + (hh * 16 + sl) * 384 + k4;
      *(float4*)(bp + 0) = make_float4(r[0], r[1], r[2], r[3]);
      *(float4*)(bp + 64) = make_float4(1.f - dp[0], 1.f - dp[1], 1.f - dp[2], 1.f - dp[3]);
      *(float4*)(bp + 128) = make_float4(k[0] * (1.f + (az[0] - 1.f) * ka[0]), k[1] * (1.f + (az[1] - 1.f) * ka[1]),
                                         k[2] * (1.f + (az[2] - 1.f) * ka[2]), k[3] * (1.f + (az[3] - 1.f) * ka[3]));
      *(float4*)(bp + 192) = make_float4(v[0], v[1], v[2], v[3]);
      *(float4*)(bp + 256) = make_float4(-kk[0], -kk[1], -kk[2], -kk[3]);
      *(float4*)(bp + 320) = make_float4(kk[0] * az[0], kk[1] * az[1], kk[2] * az[2], kk[3] * az[3]);
    }
    __syncthreads();
    if (ci + 1 < nchunks) { SCAN_GLOAD(ci + 1) }
    float ykeep0 = 0.f, ykeep1 = 0.f;
    f32x4 Lr[2][2], Lw[2][2], Lk[2][2], La[2][2], Lb[2][2];
    float Lv[2][2];
#define SCAN_LOADB(j_, slot_)                                               \
  _Pragma("unroll") for (int u = 0; u < 2; ++u) {                           \
    const float* bp = buf + ((j_) * 2 + u) * 384 + kq * 4;                  \
    Lr[slot_][u] = *(const f32x4*)(bp + 0);                                 \
    Lw[slot_][u] = *(const f32x4*)(bp + 64);                                \
    Lk[slot_][u] = *(const f32x4*)(bp + 128);                               \
    Lv[slot_][u] = buf[((j_) * 2 + u) * 384 + 192 + vrow];                  \
    La[slot_][u] = *(const f32x4*)(bp + 256);                               \
    Lb[slot_][u] = *(const f32x4*)(bp + 320);                               \
  }
    SCAN_LOADB(0, 0)
    float yprev = 0.f;
#pragma unroll
    for (int j = 0; j < 16; ++j) {
      if (j + 1 < 16) {
        SCAN_LOADB(j + 1, (j + 1) & 1)
      }
      __builtin_amdgcn_sched_barrier(0);
#pragma unroll
      for (int u = 0; u < 2; ++u) {
        const int sl2 = j & 1;
        const int st = j * 2 + u;
        const f32x4 a4 = La[sl2][u], b4 = Lb[sl2][u], w4 = Lw[sl2][u], kd = Lk[sl2][u], r4 = Lr[sl2][u];
        const float vv = Lv[sl2][u];
        f32x2 p = S01 * a4.xy;
        p = S23 * a4.zw + p;
        float sa = p.x + p.y;
        sa += dppf(sa, 0); yprev += dppf(yprev, 0);
        sa += dppf(sa, 1); yprev += dppf(yprev, 1);
        sa += dppf(sa, 2); yprev += dppf(yprev, 2);
        sa += dppf(sa, 3); yprev += dppf(yprev, 3);
        if (st >= 1 && st <= 16) ykeep0 = (kq == st - 1) ? yprev : ykeep0;
        if (st >= 17) ykeep1 = (kq == st - 17) ? yprev : ykeep1;
        const f32x2 sa2 = (f32x2){sa, sa}, vv2 = (f32x2){vv, vv};
        const f32x2 t01 = sa2 * b4.xy + vv2 * kd.xy;
        const f32x2 t23 = sa2 * b4.zw + vv2 * kd.zw;
        S01 = S01 * w4.xy + t01;
        S23 = S23 * w4.zw + t23;
        f32x2 q = S01 * r4.xy;
        q = S23 * r4.zw + q;
        yprev = q.x + q.y;
      }
    }
    yprev = red16(yprev);
    ykeep1 = (kq == 15) ? yprev : ykeep1;
    {
      const int kidx0 = kidx_of(ci * 32 + kq), kidx1 = kidx_of(ci * 32 + 16 + kq);
      YZ[(size_t)(b * TPB + kidx0) * 512 + h * 64 + rg * 16 + rowl] = f2bf(ykeep0);
      YZ[(size_t)(b * TPB + kidx1) * 512 + h * 64 + rg * 16 + rowl] = f2bf(ykeep1);
    }
    __syncthreads();
  }
}

__device__ __forceinline__ float red8(float x) {
  x += dppf8(x, 0);
  x += dppf8(x, 1);
  x += dppf8(x, 2);
  return x;
}
__device__ __forceinline__ void unpack8(const uint4 g, float (&o)[8]) {
  o[0] = __uint_as_float(g.x << 16); o[1] = __uint_as_float(g.x & 0xffff0000u);
  o[2] = __uint_as_float(g.y << 16); o[3] = __uint_as_float(g.y & 0xffff0000u);
  o[4] = __uint_as_float(g.z << 16); o[5] = __uint_as_float(g.z & 0xffff0000u);
  o[6] = __uint_as_float(g.w << 16); o[7] = __uint_as_float(g.w & 0xffff0000u);
}
__device__ __forceinline__ void phase_rwkv_out(const Params& P) {
  char* ws = P.ws;
  const bf16_t* XR = (const bf16_t*)(ws + OFF_XR);
  const bf16_t* XK = (const bf16_t*)(ws + OFF_XK);
  const bf16_t* XV = (const bf16_t*)(ws + OFF_XV);
  const bf16_t* AZ = (const bf16_t*)(ws + OFF_AZ);
  const bf16_t* YZ = (const bf16_t*)(ws + OFF_YZ);
  bf16_t* Acat = (bf16_t*)(ws + OFF_A);
  const int lane = threadIdx.x & 63, wave = threadIdx.x >> 6;
  const int c8 = lane * 8;
  float lw[8], lb[8], kav[8], rkv[8];
#pragma unroll
  for (int q = 0; q < 8; ++q) { lw[q] = P.d_ln_w[c8 + q]; lb[q] = P.d_ln_b[c8 + q]; kav[q] = P.d_k_a[c8 + q]; rkv[q] = P.d_r_k[c8 + q]; }
#pragma unroll 2
  for (int idx = blockIdx.x * 4 + wave; idx < 32768; idx += gridDim.x * 4) {
    const size_t row = (size_t)((idx >> 14) * TPB + 256 + (idx & 16383));
    const size_t off = row * 512 + c8;
    const uint4 u_y0 = *(const uint4*)(YZ + off), u_y1 = *(const uint4*)(YZ + (SZ512 / 2) + off);
    const uint4 u_r = *(const uint4*)(XR + off), u_k = *(const uint4*)(XK + off), u_v = *(const uint4*)(XV + off);
    const uint4 u_a0 = *(const uint4*)(AZ + off), u_a1 = *(const uint4*)(AZ + (SZ512 / 2) + off);
    const uint4 u_g = *(const uint4*)(Acat + row * DM + 512 + c8);
    float y0[8], y1[8], rr[8], kk_[8], vv[8], a0[8], a1[8], gg[8];
    unpack8(u_y0, y0); unpack8(u_y1, y1); unpack8(u_r, rr); unpack8(u_k, kk_); unpack8(u_v, vv);
    unpack8(u_a0, a0); unpack8(u_a1, a1); unpack8(u_g, gg);
    float y[8], sy = 0.f, sd = 0.f;
#pragma unroll
    for (int q = 0; q < 8; ++q) {
      y[q] = y0[q] + y1[q];
      sy += y[q];
      const float kd = kk_[q] * (1.f + (a0[q] - 1.f) * kav[q]) + kk_[q] * (1.f + (a1[q] - 1.f) * kav[q]);
      sd += rr[q] * kd * rkv[q];
    }
    const float mean = red8(sy) * (1.0f / 64.0f);
    const float sdot = red8(sd);
    float sv = 0.f;
#pragma unroll
    for (int q = 0; q < 8; ++q) { y[q] -= mean; sv += y[q] * y[q]; }
    const float rstd = rsqrtf(red8(sv) * (1.0f / 64.0f) + 64e-5f);
    float o[8];
#pragma unroll
    for (int q = 0; q < 8; ++q) o[q] = (y[q] * rstd * lw[q] + lb[q] + sdot * vv[q]) * gg[q];
    *(uint4*)(Acat + row * DM + 512 + c8) = make_uint4(pack2(o[0], o[1]), pack2(o[2], o[3]), pack2(o[4], o[5]), pack2(o[6], o[7]));
  }
}

#define XB_TMO      128
#define XB_XCNT(j)  (256  + 64 * (j))
#define XB_XSUB(j)  (1280 + 64 * (j))
#define XB_XGEN(j)  (2304 + 64 * (j))
#define XB_TOP      3328
#define XB_TOPGEN   3392
#define XCD_BAR_WORDS 3456
#define XB_SPIN_CAP (1u << 22)
#define LAS __attribute__((address_space(3)))
__device__ __forceinline__ unsigned xb_ld(unsigned* p) { return __hip_atomic_load(p, __ATOMIC_RELAXED, __HIP_MEMORY_SCOPE_AGENT); }
__device__ __forceinline__ unsigned xb_add(unsigned* p, unsigned v) { return __hip_atomic_fetch_add(p, v, __ATOMIC_RELAXED, __HIP_MEMORY_SCOPE_AGENT); }
__device__ __forceinline__ unsigned xb_xcc_id() { return (unsigned)__builtin_amdgcn_s_getreg((3 << 11) | 20) & 0xFu; }
#define XB_SPIN(cond, bar) do { unsigned _sp = 0; while (cond) { __builtin_amdgcn_s_sleep(1); \
    if ((++_sp & 255u) == 0u) { if (xb_ld(&(bar)[XB_TMO])) break; if (_sp > XB_SPIN_CAP) { atomicAdd(&(bar)[XB_TMO], 1u); break; } } } } while (0)
struct XcdBarrier { unsigned* bar; unsigned x; volatile LAS unsigned* st; };
__device__ __forceinline__ XcdBarrier xcd_barrier_post(unsigned* bar, volatile LAS unsigned* st) {
  XcdBarrier b; b.bar = bar; b.x = xb_xcc_id(); b.st = st;
  if (threadIdx.x == 0) (void)xb_add(&bar[XB_XCNT(b.x)], 1u);
  return b;
}
__device__ __forceinline__ void xcd_barrier_complete(unsigned* bar, unsigned x, unsigned& nloc, unsigned& nx) {
  const unsigned G = gridDim.x * gridDim.y * gridDim.z;
  unsigned sum, cnt, mine, sp = 0u;
  for (;;) {
    sum = 0u; cnt = 0u; mine = 0u;
#pragma unroll
    for (unsigned j = 0; j < 16; ++j) { const unsigned c = xb_ld(&bar[XB_XCNT(j)]); sum += c; cnt += (c > 0u) ? 1u : 0u; mine = (j == x) ? c : mine; }
    if (sum == G) break;
    __builtin_amdgcn_s_sleep(1);
    if ((++sp & 255u) == 0u) { if (xb_ld(&bar[XB_TMO])) break; if (sp > XB_SPIN_CAP) { atomicAdd(&bar[XB_TMO], 1u); break; } }
  }
  nloc = mine > 0u ? mine : 1u; nx = cnt > 0u ? cnt : 1u;
}
__device__ __forceinline__ void xcd_barrier(const XcdBarrier& b) {
  asm volatile("s_waitcnt vmcnt(0)" ::: "memory");
  __syncthreads();
  if (threadIdx.x == 0) {
    unsigned* bar = b.bar;
    __builtin_amdgcn_s_waitcnt(0);
    unsigned nloc = b.st[0], nx = b.st[1];
    if (nloc == 0u) { xcd_barrier_complete(bar, b.x, nloc, nx); b.st[0] = nloc; b.st[1] = nx; }
    const unsigned old = xb_add(&bar[XB_XSUB(b.x)], 1u);
    const unsigned gen = old / nloc;
    if (old + 1u == (gen + 1u) * nloc) {
      __builtin_amdgcn_fence(__ATOMIC_RELEASE, "agent");
      asm volatile("s_waitcnt vmcnt(0)" ::: "memory");
      const unsigned og = xb_add(&bar[XB_TOP], 1u);
      const unsigned tg = og / nx;
      if (og + 1u == (tg + 1u) * nx) xb_add(&bar[XB_TOPGEN], 1u);
      else XB_SPIN(xb_ld(&bar[XB_TOPGEN]) == tg, bar);
      __builtin_amdgcn_fence(__ATOMIC_ACQUIRE, "agent");
      xb_add(&bar[XB_XGEN(b.x)], 1u);
      asm volatile("s_waitcnt vmcnt(0)" ::: "memory");
    } else {
      XB_SPIN(xb_ld(&bar[XB_XGEN(b.x)]) == gen, bar);
      __builtin_amdgcn_fence(__ATOMIC_ACQUIRE, "agent");
      asm volatile("s_waitcnt vmcnt(0)" ::: "memory");
    }
  }
  __syncthreads();
}

#define NPHASE 18
__device__ __forceinline__ void run_phase(const Params& P, int ph, char* smem) {
  char* ws = P.ws;
  bf16_t* A = (bf16_t*)(ws + OFF_A);
  float* xctx = (float*)(ws + OFF_XCTX);
  const float* mod0 = (const float*)(ws + OFF_MOD);
  const float* mod1 = mod0 + 3 * 6144;
  const bf16_t* WIN = (const bf16_t*)(ws + OFF_WIN);
  const bf16_t* WOUT = (const bf16_t*)(ws + OFF_WOUT);
  const bf16_t* WGU = (const bf16_t*)(ws + OFF_WGU);
  const bf16_t* WDN = (const bf16_t*)(ws + OFF_WDN);
  bf16_t* ACT = (bf16_t*)(ws + OFF_ACT);
  switch (ph) {
    case 0:
      phase_conv(P, 0, smem, 0, blockIdx.x, gridDim.x);
      phase_adaln(P, smem);
      break;
    case 1:
      phase_norm(P.x, P.ctx, P.norm_mix, mod0, 0, 1024, A, false);
      break;
    case 2: {
      EpiIn0 e;
      e.a_qn = P.a_qn; e.a_kn = P.a_kn; e.b_qn = P.b_qn; e.b_kn = P.b_kn;
      e.rope = (const float*)(ws + OFF_ROPE);
      e.AQ = (bf16_t*)(ws + OFF_AQ); e.AK = (bf16_t*)(ws + OFF_AK); e.AVT = (bf16_t*)(ws + OFF_AVT);
      e.BQ = (bf16_t*)(ws + OFF_BQ); e.BK = (bf16_t*)(ws + OFF_BK); e.BVT = (bf16_t*)(ws + OFF_BVT);
      gemm_phase<false>(A, DM, WIN, 1024, 18, false, e, smem);
    } break;
    case 3:
      phase_attn0(P, smem);
      break;
    case 4: {
      EpiRes e;
      e.lat_src = P.x; e.ctx_src = P.ctx; e.lat_dst = P.out; e.ctx_dst = xctx; e.gate = mod0 + 2048;
      gemm_phase<true>(A, DM, WOUT, 1024, 8, false, e, smem);
    } break;
    case 5:
      phase_norm(P.out, xctx, P.norm_ffn, mod0, 3072, 4096, A, false);
      break;
    case 6: {
      EpiGU e;
      e.ACT = ACT;
      gemm_phase<true>(A, DM, WGU, 1024, 44, false, e, smem);
    } break;
    case 7: {
      EpiRes e;
      e.lat_src = P.out; e.ctx_src = xctx; e.lat_dst = P.out; e.ctx_dst = xctx; e.gate = mod0 + 5120;
      gemm_phase<true>(ACT, DFF, WDN, DFF, 8, false, e, smem);
    } break;
    case 8:
      phase_conv(P, 1, smem, 1, blockIdx.x, gridDim.x);
      phase_lora_conv(P);
      phase_norm(P.out, xctx, P.norm_mix + 1024, mod1, 0, 1024, A, false);
      break;
    case 9: {
      EpiIn1 e;
      e.c_qn = P.c_qn; e.c_kn = P.c_kn;
      e.CQ = (bf16_t*)(ws + OFF_CQ); e.CK = (bf16_t*)(ws + OFF_CK); e.CVT = (bf16_t*)(ws + OFF_CVT);
      e.RAW = (bf16_t*)(ws + OFF_RAW); e.LORA = (float*)(ws + OFF_LORA);
      gemm_phase<false>(A, DM, WIN, 1024, 26, false, e, smem);
    } break;
    case 10:
      phase_na(P, smem);
      break;
    case 11:
      phase_prep(P, smem);
      break;
    case 12: {
      const int kloc = blockIdx.x >> 3;
      const bool is_scan = !((kloc & 1) || kloc >= 32);
      if (is_scan) phase_scan(P, smem);
      else {
        const int kc = kloc < 32 ? kloc : 32;
        phase_conv(P, 1, smem, 2, (int)blockIdx.x - 8 * ((kc + 1) >> 1), (int)gridDim.x - 128);
      }
    } break;
    case 13:
      phase_rwkv_out(P);
      break;
    case 14: {
      EpiRes e;
      e.lat_src = P.out; e.ctx_src = xctx; e.lat_dst = P.out; e.ctx_dst = xctx; e.gate = mod1 + 2048;
      gemm_phase<true>(A, DM, WOUT, 1024, 8, true, e, smem);
    } break;
    case 15:
      phase_norm(P.out, xctx, P.norm_ffn + 1024, mod1, 3072, 4096, A, true);
      break;
    case 16: {
      EpiGU e;
      e.ACT = ACT;
      gemm_phase<true>(A, DM, WGU, 1024, 44, true, e, smem);
    } break;
    case 17: {
      EpiRes e;
      e.lat_src = P.out; e.ctx_src = xctx; e.lat_dst = P.out; e.ctx_dst = xctx; e.gate = mod1 + 5120;
      gemm_phase<true>(ACT, DFF, WDN, DFF, 8, true, e, smem);
    } break;
    default: break;
  }
}

#define SMEM_BYTES 49152

#if MEGA
template <int PH>
__device__ __forceinline__ void run_all(const Params& P, char* smem, cg::grid_group& grid, const XcdBarrier& xb) {
  run_phase(P, PH, smem);
  if constexpr (((DUP_MASK >> PH) & 1) != 0) {
    xcd_barrier(xb);
    run_phase(P, PH, smem);
  }
  if constexpr (PH + 1 < NPHASE) {
    if constexpr (PH == 0) grid.sync(); else xcd_barrier(xb);
    run_all<PH + 1>(P, smem, grid, xb);
  }
}
__global__ void __launch_bounds__(256, 2) fwd_mega(Params P) {
  extern __shared__ __attribute__((aligned(16))) char smem[];
  __shared__ uint4 xb_words;
  cg::grid_group grid = cg::this_grid();
  if (threadIdx.x == 0) xb_words = make_uint4(0u, 0u, 0u, 0u);
  __syncthreads();
  XcdBarrier xb = xcd_barrier_post((unsigned*)(P.ws + OFF_BAR), (volatile LAS unsigned*)&xb_words);
  run_all<0>(P, smem, grid, xb);
}
#else
template <int PH>
__global__ void __launch_bounds__(256, 2) fwd_phase(Params P) {
  extern __shared__ __attribute__((aligned(16))) char smem[];
  run_phase(P, PH, smem);
}
template <int PH>
static void launch_all(const Params& P, hipStream_t stream) {
  fwd_phase<PH><<<512, 256, SMEM_BYTES, stream>>>(P);
  if constexpr (PH + 1 < NPHASE) launch_all<PH + 1>(P, stream);
}
#endif

extern "C" void kernel_launch(void* const* d_in, const int* in_sizes, int n_in, void* d_out, int out_size, void* d_ws,
                              size_t ws_size, hipStream_t stream) {
  if (ws_size < WS_NEEDED) {
    fprintf(stderr, "workspace too small: %zu < %llu\n", ws_size, (unsigned long long)WS_NEEDED);
    return;
  }
  Params P{};
  const float** pp = (const float**)&P;
  for (int i = 0; i < 36; ++i) pp[i] = (const float*)d_in[i];
  P.out = (float*)d_out;
  P.ws = (char*)d_ws;
#if MEGA
  static int grid_blocks = 0;
  if (!grid_blocks) {
    int dev = 0, cus = 0, per_cu = 0;
    hipGetDevice(&dev);
    hipDeviceGetAttribute(&cus, hipDeviceAttributeMultiprocessorCount, dev);
    hipFuncSetAttribute((const void*)fwd_mega, hipFuncAttributeMaxDynamicSharedMemorySize, SMEM_BYTES);
    hipOccupancyMaxActiveBlocksPerMultiprocessor(&per_cu, fwd_mega, 256, SMEM_BYTES);
    if (per_cu > 2) per_cu = 2;
    grid_blocks = cus * per_cu;
  }
  hipMemsetAsync((char*)d_ws + OFF_BAR, 0, XCD_BAR_WORDS * sizeof(unsigned), stream);
  void* args[] = {&P};
  hipError_t e = hipLaunchCooperativeKernel((void*)fwd_mega, dim3(grid_blocks), dim3(256), args, SMEM_BYTES, stream);
  if (e != hipSuccess) fprintf(stderr, "cooperative launch failed: %s (grid %d)\n", hipGetErrorString(e), grid_blocks);
#else
  launch_all<0>(P, stream);
#endif
}
```

```cpp
#include <hip/hip_runtime.h>
#include <hip/hip_cooperative_groups.h>
#include <stdint.h>
#include <stdio.h>

namespace cg = cooperative_groups;

#ifndef MEGA
#define MEGA 1
#endif
#define DUP_MASK 0

typedef unsigned short bf16_t;
typedef short bf16x8 __attribute__((ext_vector_type(8)));
typedef short bf16x4 __attribute__((ext_vector_type(4)));
typedef float f32x4 __attribute__((ext_vector_type(4)));
typedef float f32x2 __attribute__((ext_vector_type(2)));

#define DM 1024
#define TPB 16640
#define MROWS 33280
#define DFF 2816
#define LOG2E 1.4426950408889634f
#define LSTR 80

#define OFF_WIN   0ull
#define OFF_WOUT  6815744ull
#define OFF_WGU   8912896ull
#define OFF_WDN   20447232ull
#define OFF_MISC  26214400ull
#define OFF_MOD   (OFF_MISC)
#define OFF_ROPE  (OFF_MISC + 147456ull)
#define OFF_LAM   (OFF_MISC + 180224ull)
#define OFF_BAR   (OFF_MISC + 196608ull)
#define OFF_XCTX  (OFF_MISC + 262144ull)
#define OFF_WL    (OFF_MISC + 2359296ull)
#define OFF_A     (OFF_MISC + 4194304ull)
#define OFF_BIG   (OFF_A + 68157440ull)
#define SZ512     34078720ull
#define OFF_AQ    (OFF_BIG)
#define OFF_AK    (OFF_BIG + SZ512)
#define OFF_AVT   (OFF_BIG + 2 * SZ512)
#define OFF_BQ    (OFF_BIG + 3 * SZ512)
#define OFF_BK    (OFF_BIG + 4 * SZ512)
#define OFF_BVT   (OFF_BK + 8519680ull)
#define OFF_ACT   (OFF_BIG)
#define OFF_RAW   (OFF_BIG)
#define OFF_LORA  (OFF_BIG + 102236160ull)
#define OFF_D0    (OFF_BIG + 132055040ull)
#define OFF_CQ    (OFF_D0)
#define OFF_CK    (OFF_D0 + SZ512)
#define OFF_CVT   (OFF_D0 + 2 * SZ512)
#define OFF_XR    (OFF_D0)
#define OFF_XK    (OFF_D0 + 1 * SZ512)
#define OFF_XV    (OFF_D0 + 2 * SZ512)
#define OFF_KK    (OFF_D0 + 3 * SZ512)
#define OFF_DP    (OFF_D0 + 4 * SZ512)
#define OFF_AZ    (OFF_D0 + 6 * SZ512)
#define OFF_YZ    (OFF_BIG)
#define WS_NEEDED (OFF_D0 + 8 * SZ512)

struct Params {
  const float *x, *c, *ctx, *c_ctx, *ada_w, *ada_b, *norm_mix, *norm_ffn, *w_gate, *w_up, *w_down,
      *ab_w_in, *ab_w_out, *a_qn, *a_kn, *a_lambda, *a_subln, *b_qn, *b_kn, *b_sink,
      *cd_w_in, *cd_w_out, *c_qn, *c_kn, *c_rpb, *d_mu, *d_w0, *d_w2, *d_a0, *d_a2, *d_g2,
      *d_k_k, *d_k_a, *d_r_k, *d_ln_w, *d_ln_b;
  float* out;
  char* ws;
};

__device__ __forceinline__ bf16_t f2bf(float f) {
  uint32_t u = __float_as_uint(f);
  u += 0x7fffu + ((u >> 16) & 1u);
  return (bf16_t)(u >> 16);
}
__device__ __forceinline__ float bf2f(bf16_t h) { return __uint_as_float(((uint32_t)h) << 16); }
typedef __bf16 bf16v2_t __attribute__((ext_vector_type(2)));
__device__ __forceinline__ uint32_t pack2(float a, float b) {
  const f32x2 v = (f32x2){a, b};
  const bf16v2_t r = __builtin_convertvector(v, bf16v2_t);
  return __builtin_bit_cast(uint32_t, r);
}
__device__ __forceinline__ float fexp2(float x) { return __builtin_amdgcn_exp2f(x); }
__device__ __forceinline__ float wave_sum(float v) {
#pragma unroll
  for (int o = 32; o >= 1; o >>= 1) v += __shfl_xor(v, o);
  return v;
}
__device__ __forceinline__ float sigmoidf_(float x) { return __builtin_amdgcn_rcpf(1.0f + __expf(-x)); }

template <bool DEEP, class Epi>
__device__ __forceinline__ void gemm_phase(const bf16_t* __restrict__ A, int lda, const bf16_t* __restrict__ Wt,
                                           int K, int ntn, bool lat_only, const Epi& epi, char* smem) {
  bf16_t* sA = (bf16_t*)smem;
  bf16_t* sB = sA + 128 * LSTR;
  int tid = threadIdx.x;
  asm volatile("" : "+v"(tid));
  const int lane = tid & 63, wave = tid >> 6;
  const int wm = wave >> 1, wn = wave & 1;
  const int l15 = lane & 15, quad = lane >> 4;
  const int ntm = lat_only ? 256 : 260;
  const int total = ntm * ntn;
  const int lr = tid >> 3, lc = (tid & 7) * 8;
  const bool swz = (gridDim.x & 7) == 0;
  const int xcd = swz ? (blockIdx.x & 7) : 0, lb = swz ? (blockIdx.x >> 3) : blockIdx.x, nlb = swz ? (gridDim.x >> 3) : gridDim.x;
  const int m_lo = swz ? (ntm * xcd) / 8 : 0, m_hi = swz ? (ntm * (xcd + 1)) / 8 : ntm;
  const int nm = m_hi - m_lo;
  const int total_x = nm * ntn;
  (void)total;
  for (int t = lb; t < total_x; t += nlb) {
    const int g = t / (8 * ntn), r = t - g * 8 * ntn;
    const int gsz = min(8, nm - g * 8);
    const int ni = r / gsz, mm = r - ni * gsz;
    const int mi = m_lo + g * 8 + mm;
    const int mt = lat_only ? ((mi >> 7) * 130 + 2 + (mi & 127)) : mi;
    const int row0 = mt * 128, col0 = ni * 128;
    const bf16_t* Ap = A + (size_t)(row0 + lr) * lda + lc;
    const bf16_t* Bp = Wt + (size_t)(col0 + lr) * K + lc;
    f32x4 acc[4][4];
#pragma unroll
    for (int i = 0; i < 4; ++i)
#pragma unroll
      for (int j = 0; j < 4; ++j) acc[i][j] = (f32x4){0.f, 0.f, 0.f, 0.f};
    uint4 ra0, ra1, ra2, ra3, rb0, rb1, rb2, rb3;
    uint4 rc0, rc1, rc2, rc3, rd0, rd1, rd2, rd3;
#define GEMM_LOAD(a0, a1, a2, a3, b0, b1, b2, b3, kk_)        \
  {                                                           \
    a0 = *(const uint4*)(Ap + (kk_));                         \
    a1 = *(const uint4*)(Ap + (size_t)32 * lda + (kk_));      \
    a2 = *(const uint4*)(Ap + (size_t)64 * lda + (kk_));      \
    a3 = *(const uint4*)(Ap + (size_t)96 * lda + (kk_));      \
    b0 = *(const uint4*)(Bp + (kk_));                         \
    b1 = *(const uint4*)(Bp + (size_t)32 * K + (kk_));        \
    b2 = *(const uint4*)(Bp + (size_t)64 * K + (kk_));        \
    b3 = *(const uint4*)(Bp + (size_t)96 * K + (kk_));        \
  }
#define GEMM_STORE(a0, a1, a2, a3, b0, b1, b2, b3, buf_)                   \
  {                                                                        \
    bf16_t* wa = sA + (buf_) * (256 * LSTR);                               \
    bf16_t* wb = wa + 128 * LSTR;                                          \
    *(uint4*)(wa + (lr) * LSTR + lc) = a0;                                 \
    *(uint4*)(wa + (lr + 32) * LSTR + lc) = a1;                            \
    *(uint4*)(wa + (lr + 64) * LSTR + lc) = a2;                            \
    *(uint4*)(wa + (lr + 96) * LSTR + lc) = a3;                            \
    *(uint4*)(wb + (lr) * LSTR + lc) = b0;                                 \
    *(uint4*)(wb + (lr + 32) * LSTR + lc) = b1;                            \
    *(uint4*)(wb + (lr + 64) * LSTR + lc) = b2;                            \
    *(uint4*)(wb + (lr + 96) * LSTR + lc) = b3;                            \
  }
#define GEMM_MMA(buf_, ks_)                                                                                              \
  {                                                                                                                      \
    const bf16_t* ca = sA + (buf_) * (256 * LSTR);                                                                       \
    const bf16_t* cb = ca + 128 * LSTR;                                                                                  \
    bf16x8 af[4], bfr[4];                                                                                                \
    _Pragma("unroll") for (int i = 0; i < 4; ++i)                                                                        \
        af[i] = *(const bf16x8*)(ca + (wm * 64 + i * 16 + l15) * LSTR + (ks_) * 32 + quad * 8);                         \
    _Pragma("unroll") for (int j = 0; j < 4; ++j)                                                                        \
        bfr[j] = *(const bf16x8*)(cb + (wn * 64 + j * 16 + l15) * LSTR + (ks_) * 32 + quad * 8);                        \
    _Pragma("unroll") for (int i = 0; i < 4; ++i) _Pragma("unroll") for (int j = 0; j < 4; ++j)                          \
        acc[i][j] = __builtin_amdgcn_mfma_f32_16x16x32_bf16(bfr[j], af[i], acc[i][j], 0, 0, 0);                         \
  }
    const int nk = K >> 6;
    GEMM_LOAD(ra0, ra1, ra2, ra3, rb0, rb1, rb2, rb3, 0)
    (void)rc0; (void)rc1; (void)rc2; (void)rc3; (void)rd0; (void)rd1; (void)rd2; (void)rd3;
#pragma clang loop unroll(disable)
    for (int kt = 0; kt < nk; ++kt) {
      __syncthreads();
      GEMM_STORE(ra0, ra1, ra2, ra3, rb0, rb1, rb2, rb3, 0)
      __syncthreads();
      {
        bf16x8 af0[4], bf0[4], af1[4], bf1[4];
        __builtin_amdgcn_s_setprio(1);
#pragma unroll
        for (int i = 0; i < 4; ++i) af0[i] = *(const bf16x8*)(sA + (wm * 64 + i * 16 + l15) * LSTR + quad * 8);
#pragma unroll
        for (int j = 0; j < 4; ++j) bf0[j] = *(const bf16x8*)(sB + (wn * 64 + j * 16 + l15) * LSTR + quad * 8);
#pragma unroll
        for (int i = 0; i < 4; ++i) af1[i] = *(const bf16x8*)(sA + (wm * 64 + i * 16 + l15) * LSTR + 32 + quad * 8);
#pragma unroll
        for (int j = 0; j < 4; ++j) bf1[j] = *(const bf16x8*)(sB + (wn * 64 + j * 16 + l15) * LSTR + 32 + quad * 8);
        __builtin_amdgcn_sched_barrier(0);
        if (kt + 1 < nk) GEMM_LOAD(ra0, ra1, ra2, ra3, rb0, rb1, rb2, rb3, (kt + 1) * 64)
        __builtin_amdgcn_sched_barrier(0);
#pragma unroll
        for (int i = 0; i < 4; ++i)
#pragma unroll
          for (int j = 0; j < 4; ++j) acc[i][j] = __builtin_amdgcn_mfma_f32_16x16x32_bf16(bf0[j], af0[i], acc[i][j], 0, 0, 0);
#pragma unroll
        for (int i = 0; i < 4; ++i)
#pragma unroll
          for (int j = 0; j < 4; ++j) acc[i][j] = __builtin_amdgcn_mfma_f32_16x16x32_bf16(bf1[j], af1[i], acc[i][j], 0, 0, 0);
        __builtin_amdgcn_s_setprio(0);
      }
    }
    asm volatile("" ::: "memory");
    epi(acc, row0 + wm * 64, col0 + wn * 64, l15, quad);
  }
}

struct EpiIn0 {
  const float *a_qn, *a_kn, *b_qn, *b_kn, *rope;
  bf16_t *AQ, *AK, *AVT, *BQ, *BK, *BVT;
  __device__ __forceinline__ void operator()(const f32x4 (&acc)[4][4], int row0w, int col0w, int l15, int quad) const {
    const int cb = col0w >> 6;
    int kind;
    const float* gain = nullptr;
    bool isq = false;
    if (cb < 8) { kind = 0; gain = a_qn; isq = true; }
    else if (cb < 16) { kind = 1; gain = a_kn; }
    else if (cb < 24) { kind = 2; }
    else if (cb < 32) { kind = 3; gain = b_qn; isq = true; }
    else if (cb < 34) { kind = 4; gain = b_kn; }
    else { kind = 5; }
#pragma unroll
    for (int i = 0; i < 4; ++i) {
      __builtin_amdgcn_sched_barrier(0);
      const int row = row0w + i * 16 + l15;
      const int b = row / TPB, kidx = row - b * TPB;
      float v[4][4];
#pragma unroll
      for (int j = 0; j < 4; ++j)
#pragma unroll
        for (int e = 0; e < 4; ++e) v[j][e] = acc[i][j][e];
      if (gain) {
        float ss = 0.f;
#pragma unroll
        for (int j = 0; j < 4; ++j)
#pragma unroll
          for (int e = 0; e < 4; ++e) ss += v[j][e] * v[j][e];
        ss += __shfl_xor(ss, 16);
        ss += __shfl_xor(ss, 32);
        const float rstd = rsqrtf(ss * (1.0f / 64.0f) + 1e-6f);
#pragma unroll
        for (int j = 0; j < 4; ++j)
#pragma unroll
          for (int e = 0; e < 4; ++e) v[j][e] *= rstd * gain[j * 16 + quad * 4 + e];
        if (kidx >= 256) {
          const int t = kidx - 256, pr = t >> 6, pc = t & 63;
#pragma unroll
          for (int e = 0; e < 4; ++e) {
            const int f = quad * 4 + e;
            const float cr = rope[(pr * 16 + f) * 2], sr = rope[(pr * 16 + f) * 2 + 1];
            const float cc = rope[(pc * 16 + f) * 2], sc = rope[(pc * 16 + f) * 2 + 1];
            float x1 = v[0][e], x2 = v[1][e];
            v[0][e] = x1 * cr - x2 * sr;
            v[1][e] = x2 * cr + x1 * sr;
            x1 = v[2][e]; x2 = v[3][e];
            v[2][e] = x1 * cc - x2 * sc;
            v[3][e] = x2 * cc + x1 * sc;
          }
        }
        if (isq) {
#pragma unroll
          for (int j = 0; j < 4; ++j)
#pragma unroll
            for (int e = 0; e < 4; ++e) v[j][e] *= 0.125f * LOG2E;
        }
      }
      if (kind == 2) {
#pragma unroll
        for (int j = 0; j < 4; ++j)
#pragma unroll
          for (int e = 0; e < 4; ++e) {
            const int c = (cb - 16) * 64 + j * 16 + quad * 4 + e;
            AVT[((size_t)(b * 4 + (c >> 7)) * 128 + (c & 127)) * TPB + kidx] = f2bf(v[j][e]);
          }
      } else if (kind == 5) {
#pragma unroll
        for (int j = 0; j < 4; ++j)
#pragma unroll
          for (int e = 0; e < 4; ++e) {
            const int d = j * 16 + quad * 4 + e;
            BVT[((size_t)(b * 2 + (cb - 34)) * 64 + d) * TPB + kidx] = f2bf(v[j][e]);
          }
      } else {
        bf16_t* dst;
        if (kind == 0) dst = AQ + (size_t)row * 512 + cb * 64;
        else if (kind == 1) dst = AK + (size_t)row * 512 + (cb - 8) * 64;
        else if (kind == 3) dst = BQ + (size_t)row * 512 + (cb - 24) * 64;
        else dst = BK + (size_t)row * 128 + (cb - 32) * 64;
#pragma unroll
        for (int j = 0; j < 4; ++j) {
          uint2 w;
          w.x = pack2(v[j][0], v[j][1]);
          w.y = pack2(v[j][2], v[j][3]);
          *(uint2*)(dst + j * 16 + quad * 4) = w;
        }
      }
    }
  }
};

struct EpiIn1 {
  const float *c_qn, *c_kn;
  bf16_t *CQ, *CK, *CVT, *RAW;
  float* LORA;
  __device__ __forceinline__ void operator()(const f32x4 (&acc)[4][4], int row0w, int col0w, int l15, int quad) const {
    const int cb = col0w >> 6;
#pragma unroll
    for (int i = 0; i < 4; ++i) {
      const int row = row0w + i * 16 + l15;
      const int b = row / TPB, kidx = row - b * TPB;
      float v[4][4];
#pragma unroll
      for (int j = 0; j < 4; ++j)
#pragma unroll
        for (int e = 0; e < 4; ++e) v[j][e] = acc[i][j][e];
      if (cb < 16) {
        const float* gain = cb < 8 ? c_qn : c_kn;
        float ss = 0.f;
#pragma unroll
        for (int j = 0; j < 4; ++j)
#pragma unroll
          for (int e = 0; e < 4; ++e) ss += v[j][e] * v[j][e];
        ss += __shfl_xor(ss, 16);
        ss += __shfl_xor(ss, 32);
        const float rstd = rsqrtf(ss * (1.0f / 64.0f) + 1e-6f) * (cb < 8 ? 0.125f * LOG2E : 1.0f);
        bf16_t* dst = (cb < 8 ? CQ + (size_t)row * 512 + cb * 64 : CK + (size_t)row * 512 + (cb - 8) * 64);
#pragma unroll
        for (int j = 0; j < 4; ++j) {
          const float* gp = gain + j * 16 + quad * 4;
          uint2 w;
          w.x = pack2(v[j][0] * rstd * gp[0], v[j][1] * rstd * gp[1]);
          w.y = pack2(v[j][2] * rstd * gp[2], v[j][3] * rstd * gp[3]);
          *(uint2*)(dst + j * 16 + quad * 4) = w;
        }
      } else if (cb < 24) {
#pragma unroll
        for (int j = 0; j < 4; ++j)
#pragma unroll
          for (int e = 0; e < 4; ++e) {
            const int d = j * 16 + quad * 4 + e;
            CVT[((size_t)(b * 8 + (cb - 16)) * 64 + d) * TPB + kidx] = f2bf(v[j][e]);
          }
      } else if (cb < 48) {
        bf16_t* dst = RAW + (size_t)row * 1536 + (cb - 24) * 64;
#pragma unroll
        for (int j = 0; j < 4; ++j) {
          uint2 w;
          w.x = pack2(v[j][0], v[j][1]);
          w.y = pack2(v[j][2], v[j][3]);
          *(uint2*)(dst + j * 16 + quad * 4) = w;
        }
      } else {
#pragma unroll
        for (int j = 0; j < 4; ++j) {
          const int c = (cb - 48) * 64 + j * 16 + quad * 4;
          if (c < 224) *(float4*)(LORA + (size_t)row * 224 + c) = make_float4(v[j][0], v[j][1], v[j][2], v[j][3]);
        }
      }
    }
  }
};

struct EpiRes {
  const float *lat_src, *ctx_src;
  float *lat_dst, *ctx_dst;
  const float* gate;
  __device__ __forceinline__ void operator()(const f32x4 (&acc)[4][4], int row0w, int col0w, int l15, int quad) const {
#pragma unroll
    for (int i = 0; i < 4; ++i) {
      const int row = row0w + i * 16 + l15;
      const int b = row / TPB, kidx = row - b * TPB;
      const bool isc = kidx < 256;
      const size_t off = isc ? (size_t)(b * 256 + kidx) * DM : (size_t)(b * 16384 + kidx - 256) * DM;
      const float* src = (isc ? ctx_src : lat_src) + off;
      float* dst = (isc ? ctx_dst : lat_dst) + off;
      const float* g = gate + (isc ? 2 : b) * 6144;
#pragma unroll
      for (int j = 0; j < 4; ++j) {
        const int n = col0w + j * 16 + quad * 4;
        const float4 xo = *(const float4*)(src + n);
        const float4 g4 = *(const float4*)(g + n);
        float4 o;
        o.x = xo.x + g4.x * acc[i][j][0];
        o.y = xo.y + g4.y * acc[i][j][1];
        o.z = xo.z + g4.z * acc[i][j][2];
        o.w = xo.w + g4.w * acc[i][j][3];
        *(float4*)(dst + n) = o;
      }
    }
  }
};

struct EpiGU {
  bf16_t* ACT;
  __device__ __forceinline__ void operator()(const f32x4 (&acc)[4][4], int row0w, int col0w, int l15, int quad) const {
    const int chunk = col0w >> 6;
#pragma unroll
    for (int i = 0; i < 4; ++i) {
      const int row = row0w + i * 16 + l15;
#pragma unroll
      for (int j = 0; j < 2; ++j) {
        float r[4];
#pragma unroll
        for (int e = 0; e < 4; ++e) {
          const float g = acc[i][j][e], u = acc[i][j + 2][e];
          r[e] = g * sigmoidf_(g) * u;
        }
        uint2 w;
        w.x = pack2(r[0], r[1]);
        w.y = pack2(r[2], r[3]);
        *(uint2*)(ACT + (size_t)row * DFF + chunk * 32 + j * 16 + quad * 4) = w;
      }
    }
  }
};

template <int NMAP, int NDT, int MODE, bool FIXED>
__device__ __forceinline__ void attn_unit(const bf16_t* __restrict__ Qp, int ldq, const bf16_t* __restrict__ Kp, int ldk,
                                          const bf16_t* __restrict__ Vtp, int seg_lo, int nseg, int qk0,
                                          const float* s_rpb, int na_i, int na_r0, float negM,
                                          f32x4 (&o)[NMAP][NDT], float (&m)[NMAP], float (&l)[NMAP], char* smem) {
  bf16_t* sK = (bf16_t*)smem;
  bf16_t* sVt = sK + NMAP * 64 * LSTR;
  int tid = threadIdx.x;
  asm volatile("" : "+v"(tid));
  const int lane = tid & 63, wave = tid >> 6;
  const int l15 = lane & 15, quad = lane >> 4;
  bf16x8 qf[NMAP][2];
  {
    const bf16_t* qrow = Qp + (size_t)(wave * 16 + l15) * ldq;
#pragma unroll
    for (int c = 0; c < NMAP; ++c)
#pragma unroll
      for (int ks = 0; ks < 2; ++ks) qf[c][ks] = *(const bf16x8*)(qrow + c * 64 + ks * 32 + quad * 8);
  }
#pragma unroll
  for (int c = 0; c < NMAP; ++c) {
    m[c] = -1e30f;
    l[c] = 0.f;
#pragma unroll
    for (int dt = 0; dt < NDT; ++dt) o[c][dt] = (f32x4){0.f, 0.f, 0.f, 0.f};
  }
  const int ntiles = 4 + nseg;
  constexpr int NVL = NDT / 2;
  uint4 rk00, rk01, rk10, rk11, rv0, rv1, rv2, rv3;
  rk10 = rk11 = rv2 = rv3 = make_uint4(0, 0, 0, 0);
  const int lr = tid >> 3, lch = (tid & 7) * 8;
  const uint32_t koff0 = (uint32_t)(lr * ldk + lch) * 2u, koff1 = (uint32_t)((lr + 32) * ldk + lch) * 2u;
  const uint32_t voff0 = (uint32_t)(lr * TPB + lch) * 2u, voff1 = (uint32_t)((lr + 32) * TPB + lch) * 2u,
                 voff2 = (uint32_t)((lr + 64) * TPB + lch) * 2u, voff3 = (uint32_t)((lr + 96) * TPB + lch) * 2u;
#define ATTN_LOAD_K(k0_)                                              \
  {                                                                   \
    const char* kb = (const char*)(Kp + (size_t)(k0_) * ldk);         \
    rk00 = *(const uint4*)(kb + koff0);                               \
    rk01 = *(const uint4*)(kb + koff1);                               \
    if (NMAP > 1) {                                                   \
      rk10 = *(const uint4*)(kb + 128 + koff0);                       \
      rk11 = *(const uint4*)(kb + 128 + koff1);                       \
    }                                                                 \
  }
#define ATTN_LOAD_V(k0_)                                              \
  {                                                                   \
    const char* vb = (const char*)(Vtp + (k0_));                      \
    rv0 = *(const uint4*)(vb + voff0);                                \
    rv1 = *(const uint4*)(vb + voff1);                                \
    if (NVL > 2) {                                                    \
      rv2 = *(const uint4*)(vb + voff2);                              \
      rv3 = *(const uint4*)(vb + voff3);                              \
    }                                                                 \
  }
  ATTN_LOAD_K(0)
  ATTN_LOAD_V(0)
  for (int n = 0; n < ntiles; ++n) {
    const int kidx0 = (MODE == 0) ? n * 64 : (n < 4 ? n * 64 : seg_lo + (n - 4) * 64);
    __syncthreads();
    *(uint4*)(sK + (lr) * LSTR + lch) = rk00;
    *(uint4*)(sK + (lr + 32) * LSTR + lch) = rk01;
    if (NMAP > 1) {
      *(uint4*)(sK + (64 + lr) * LSTR + lch) = rk10;
      *(uint4*)(sK + (64 + lr + 32) * LSTR + lch) = rk11;
    }
    *(uint4*)(sVt + (lr) * LSTR + lch) = rv0;
    *(uint4*)(sVt + (lr + 32) * LSTR + lch) = rv1;
    if (NVL > 2) {
      *(uint4*)(sVt + (lr + 64) * LSTR + lch) = rv2;
      *(uint4*)(sVt + (lr + 96) * LSTR + lch) = rv3;
    }
    __syncthreads();
    const int knext = (MODE == 0) ? (n + 1) * 64 : ((n + 1) < 4 ? (n + 1) * 64 : seg_lo + (n + 1 - 4) * 64);
    if (n + 1 < ntiles) {
      ATTN_LOAD_K(knext)
    }
    bf16x8 pf[NMAP][2];
#pragma unroll
    for (int c = 0; c < NMAP; ++c) {
      f32x4 s[4];
#pragma unroll
      for (int kt = 0; kt < 4; ++kt) {
        const float ini = FIXED ? negM : 0.f;
        s[kt] = (f32x4){ini, ini, ini, ini};
        const int krow = 32 * (kt >> 1) + (l15 >> 2) * 8 + (kt & 1) * 4 + (l15 & 3);
#pragma unroll
        for (int ks = 0; ks < 2; ++ks) {
          const bf16x8 kf = *(const bf16x8*)(sK + (c * 64 + krow) * LSTR + ks * 32 + quad * 8);
          s[kt] = __builtin_amdgcn_mfma_f32_16x16x32_bf16(kf, qf[c][ks], s[kt], 0, 0, 0);
        }
      }
      if (MODE == 1 && n >= 4) {
        const int kp0 = kidx0 - 256, qp = qk0 - 256 + wave * 16 + l15;
#pragma unroll
        for (int kt = 0; kt < 4; ++kt)
#pragma unroll
          for (int e = 0; e < 4; ++e) {
            const int d = qp - (kp0 + 32 * (kt >> 1) + quad * 8 + (kt & 1) * 4 + e);
            if (d > 128 || d < -128) s[kt][e] = -1e30f;
          }
      }
      if (MODE == 2 && n >= 4) {
        const int ri = na_r0 + (n - 4) - na_i + 7;
        const int qc = wave * 16 + l15;
        const int cs = min(max(qc - 8, 0), 48);
#pragma unroll
        for (int kt = 0; kt < 4; ++kt)
#pragma unroll
          for (int e = 0; e < 4; ++e) {
            const int kc = 32 * (kt >> 1) + quad * 8 + (kt & 1) * 4 + e;
            if (kc >= cs && kc < cs + 16) s[kt][e] += s_rpb[ri * 31 + kc - qc + 15];
            else s[kt][e] = -1e30f;
          }
      }
      if (FIXED) {
        float ls = 0.f;
#pragma unroll
        for (int kt = 0; kt < 4; ++kt)
#pragma unroll
          for (int e = 0; e < 4; ++e) {
            s[kt][e] = fexp2(s[kt][e]);
            ls += s[kt][e];
          }
        l[c] += ls;
      } else {
        float mx = s[0][0];
#pragma unroll
        for (int kt = 0; kt < 4; ++kt)
#pragma unroll
          for (int e = 0; e < 4; ++e) mx = fmaxf(mx, s[kt][e]);
        mx = fmaxf(mx, __shfl_xor(mx, 16));
        mx = fmaxf(mx, __shfl_xor(mx, 32));
        const float mnew = fmaxf(m[c], mx);
        const float alpha = fexp2(m[c] - mnew);
        m[c] = mnew;
        float ls = 0.f;
#pragma unroll
        for (int kt = 0; kt < 4; ++kt)
#pragma unroll
          for (int e = 0; e < 4; ++e) {
            s[kt][e] = fexp2(s[kt][e] - mnew);
            ls += s[kt][e];
          }
        l[c] = l[c] * alpha + ls;
        if (__ballot(alpha != 1.0f) != 0ull) {
#pragma unroll
          for (int dt = 0; dt < NDT; ++dt) o[c][dt] *= alpha;
        }
      }
      __builtin_amdgcn_sched_barrier(0);
#pragma unroll
      for (int ks2 = 0; ks2 < 2; ++ks2) {
        union { uint32_t u[4]; bf16x8 v; } pk;
        pk.u[0] = pack2(s[2 * ks2][0], s[2 * ks2][1]);
        pk.u[1] = pack2(s[2 * ks2][2], s[2 * ks2][3]);
        pk.u[2] = pack2(s[2 * ks2 + 1][0], s[2 * ks2 + 1][1]);
        pk.u[3] = pack2(s[2 * ks2 + 1][2], s[2 * ks2 + 1][3]);
        pf[c][ks2] = pk.v;
      }
    }
    if (n + 1 < ntiles) {
      ATTN_LOAD_V(knext)
    }
#pragma unroll
    for (int ks2 = 0; ks2 < 2; ++ks2) {
      __builtin_amdgcn_sched_barrier(0);
#pragma unroll
      for (int dt = 0; dt < NDT; ++dt) {
        const bf16x8 vf = *(const bf16x8*)(sVt + (dt * 16 + l15) * LSTR + 32 * ks2 + quad * 8);
#pragma unroll
        for (int c = 0; c < NMAP; ++c) o[c][dt] = __builtin_amdgcn_mfma_f32_16x16x32_bf16(vf, pf[c][ks2], o[c][dt], 0, 0, 0);
      }
    }
  }
#pragma unroll
  for (int c = 0; c < NMAP; ++c) {
    l[c] += __shfl_xor(l[c], 16);
    l[c] += __shfl_xor(l[c], 32);
  }
}

__device__ __forceinline__ void attn_diff32(const bf16_t* __restrict__ Qp, const bf16_t* __restrict__ Kp,
                                            const bf16_t* __restrict__ Vtp, int ntiles, float negM,
                                            f32x4 (&o)[2][8], float (&l)[2], char* smem) {
  bf16_t* sK = (bf16_t*)smem;
  bf16_t* sVt = sK + 2 * 64 * LSTR;
  int tid = threadIdx.x;
  asm volatile("" : "+v"(tid));
  const int lane = tid & 63, wave = tid >> 6;
  const int l15 = lane & 15, quad = lane >> 4;
  const int cmap = wave >> 1, qg = wave & 1;
  bf16x8 qf[2][2];
#pragma unroll
  for (int qt = 0; qt < 2; ++qt) {
    const bf16_t* qrow = Qp + (size_t)(qg * 32 + qt * 16 + l15) * 512 + cmap * 64;
#pragma unroll
    for (int ks = 0; ks < 2; ++ks) qf[qt][ks] = *(const bf16x8*)(qrow + ks * 32 + quad * 8);
  }
#pragma unroll
  for (int qt = 0; qt < 2; ++qt) {
    l[qt] = 0.f;
#pragma unroll
    for (int dt = 0; dt < 8; ++dt) o[qt][dt] = (f32x4){0.f, 0.f, 0.f, 0.f};
  }
  uint4 rk00, rk01, rk10, rk11, rv0, rv1, rv2, rv3;
  const int lr = tid >> 3, lch = (tid & 7) * 8;
  const uint32_t koff0 = (uint32_t)(lr * 512 + lch) * 2u, koff1 = (uint32_t)((lr + 32) * 512 + lch) * 2u;
  const uint32_t voff0 = (uint32_t)(lr * TPB + lch) * 2u, voff1 = (uint32_t)((lr + 32) * TPB + lch) * 2u,
                 voff2 = (uint32_t)((lr + 64) * TPB + lch) * 2u, voff3 = (uint32_t)((lr + 96) * TPB + lch) * 2u;
#define AD_LOAD_K(k0_)                                                \
  {                                                                   \
    const char* kb = (const char*)(Kp + (size_t)(k0_) * 512);         \
    rk00 = *(const uint4*)(kb + koff0);                               \
    rk01 = *(const uint4*)(kb + koff1);                               \
    rk10 = *(const uint4*)(kb + 128 + koff0);                         \
    rk11 = *(const uint4*)(kb + 128 + koff1);                         \
  }
#define AD_LOAD_V(k0_)                                                \
  {                                                                   \
    const char* vb = (const char*)(Vtp + (k0_));                      \
    rv0 = *(const uint4*)(vb + voff0);                                \
    rv1 = *(const uint4*)(vb + voff1);                                \
    rv2 = *(const uint4*)(vb + voff2);                                \
    rv3 = *(const uint4*)(vb + voff3);                                \
  }
  AD_LOAD_K(0)
  AD_LOAD_V(0)
  const bf16_t* sKc = sK + cmap * 64 * LSTR;
  for (int n = 0; n < ntiles; ++n) {
    __syncthreads();
    *(uint4*)(sK + (lr) * LSTR + lch) = rk00;
    *(uint4*)(sK + (lr + 32) * LSTR + lch) = rk01;
    *(uint4*)(sK + (64 + lr) * LSTR + lch) = rk10;
    *(uint4*)(sK + (64 + lr + 32) * LSTR + lch) = rk11;
    *(uint4*)(sVt + (lr) * LSTR + lch) = rv0;
    *(uint4*)(sVt + (lr + 32) * LSTR + lch) = rv1;
    *(uint4*)(sVt + (lr + 64) * LSTR + lch) = rv2;
    *(uint4*)(sVt + (lr + 96) * LSTR + lch) = rv3;
    __syncthreads();
    const int knext = (n + 1) * 64;
    if (n + 1 < ntiles) { AD_LOAD_K(knext) }
    f32x4 s[2][4];
    __builtin_amdgcn_s_setprio(1);
#pragma unroll
    for (int kt = 0; kt < 4; ++kt) {
      s[0][kt] = (f32x4){negM, negM, negM, negM};
      s[1][kt] = (f32x4){negM, negM, negM, negM};
      const int krow = 32 * (kt >> 1) + (l15 >> 2) * 8 + (kt & 1) * 4 + (l15 & 3);
#pragma unroll
      for (int ks = 0; ks < 2; ++ks) {
        const bf16x8 kf = *(const bf16x8*)(sKc + krow * LSTR + ks * 32 + quad * 8);
        s[0][kt] = __builtin_amdgcn_mfma_f32_16x16x32_bf16(kf, qf[0][ks], s[0][kt], 0, 0, 0);
        s[1][kt] = __builtin_amdgcn_mfma_f32_16x16x32_bf16(kf, qf[1][ks], s[1][kt], 0, 0, 0);
      }
    }
    __builtin_amdgcn_s_setprio(0);
    bf16x8 pf[2][2];
#pragma unroll
    for (int qt = 0; qt < 2; ++qt) {
      float ls = 0.f;
#pragma unroll
      for (int kt = 0; kt < 4; ++kt)
#pragma unroll
        for (int e = 0; e < 4; ++e) {
          s[qt][kt][e] = fexp2(s[qt][kt][e]);
          ls += s[qt][kt][e];
        }
      l[qt] += ls;
#pragma unroll
      for (int ks2 = 0; ks2 < 2; ++ks2) {
        union { uint32_t u[4]; bf16x8 v; } pk;
        pk.u[0] = pack2(s[qt][2 * ks2][0], s[qt][2 * ks2][1]);
        pk.u[1] = pack2(s[qt][2 * ks2][2], s[qt][2 * ks2][3]);
        pk.u[2] = pack2(s[qt][2 * ks2 + 1][0], s[qt][2 * ks2 + 1][1]);
        pk.u[3] = pack2(s[qt][2 * ks2 + 1][2], s[qt][2 * ks2 + 1][3]);
        pf[qt][ks2] = pk.v;
      }
    }
    if (n + 1 < ntiles) { AD_LOAD_V(knext) }
    __builtin_amdgcn_s_setprio(1);
#pragma unroll
    for (int ks2 = 0; ks2 < 2; ++ks2)
#pragma unroll
      for (int dt = 0; dt < 8; ++dt) {
        const bf16x8 vf = *(const bf16x8*)(sVt + (dt * 16 + l15) * LSTR + 32 * ks2 + quad * 8);
        o[0][dt] = __builtin_amdgcn_mfma_f32_16x16x32_bf16(vf, pf[0][ks2], o[0][dt], 0, 0, 0);
        o[1][dt] = __builtin_amdgcn_mfma_f32_16x16x32_bf16(vf, pf[1][ks2], o[1][dt], 0, 0, 0);
      }
    __builtin_amdgcn_s_setprio(0);
  }
#pragma unroll
  for (int qt = 0; qt < 2; ++qt) {
    l[qt] += __shfl_xor(l[qt], 16);
    l[qt] += __shfl_xor(l[qt], 32);
  }
}

__device__ __forceinline__ void phase_attn0(const Params& P, char* smem) {
  char* ws = P.ws;
  const bf16_t* AQ = (const bf16_t*)(ws + OFF_AQ);
  const bf16_t* AK = (const bf16_t*)(ws + OFF_AK);
  const bf16_t* AVT = (const bf16_t*)(ws + OFF_AVT);
  const bf16_t* BQ = (const bf16_t*)(ws + OFF_BQ);
  const bf16_t* BK = (const bf16_t*)(ws + OFF_BK);
  const bf16_t* BVT = (const bf16_t*)(ws + OFF_BVT);
  bf16_t* Acat = (bf16_t*)(ws + OFF_A);
  const float lam = ((const float*)(ws + OFF_LAM))[0];
  const float negM = -((const float*)(ws + OFF_LAM))[1];
  const bool fixed_ok = ((const float*)(ws + OFF_LAM))[1] < 60.0f;
  const float lambda_init = 0.2f;
  const int lane = threadIdx.x & 63, wave = threadIdx.x >> 6, l15 = lane & 15, quad = lane >> 4;
  for (int u = blockIdx.x; u < 2080; u += gridDim.x) {
    int b, head, qb;
    if (u < 2048) {
      const int bh = u & 7;
      b = bh >> 2; head = bh & 3; qb = 4 + (u >> 3);
    }
    else { const int cu = u - 2048; b = cu >> 4; head = (cu >> 2) & 3; qb = cu & 3; }
    const int qk0 = qb * 64;
    const int nseg = qb >= 4 ? 256 : 0;
    f32x4 o[2][8];
    float m[2], l[2];
    if (fixed_ok) {
      f32x4 o2[2][8];
      float l2[2];
      attn_diff32(AQ + (size_t)(b * TPB + qk0) * 512 + head * 128, AK + (size_t)(b * TPB) * 512 + head * 128,
                  AVT + (size_t)(b * 4 + head) * 128 * TPB, 4 + nseg, negM, o2, l2, smem);
      float* xch = (float*)smem;
      const int cmap = wave >> 1, qg = wave & 1;
      __syncthreads();
      if (cmap == 1) {
#pragma unroll
        for (int qt = 0; qt < 2; ++qt) {
          const float i1 = lam / l2[qt];
#pragma unroll
          for (int dt = 0; dt < 8; ++dt)
            *(f32x4*)(xch + (size_t)((qg * 32 + qt * 16 + l15) * 128 + dt * 16 + quad * 4)) = o2[qt][dt] * i1;
        }
      }
      __syncthreads();
      if (cmap == 0) {
#pragma unroll
        for (int qt = 0; qt < 2; ++qt) {
          const float i0 = 1.0f / l2[qt];
          float ss = 0.f;
#pragma unroll
          for (int dt = 0; dt < 8; ++dt) {
            const f32x4 other = *(const f32x4*)(xch + (size_t)((qg * 32 + qt * 16 + l15) * 128 + dt * 16 + quad * 4));
            o2[qt][dt] = o2[qt][dt] * i0 - other;
#pragma unroll
            for (int e = 0; e < 4; ++e) ss += o2[qt][dt][e] * o2[qt][dt][e];
          }
          ss += __shfl_xor(ss, 16);
          ss += __shfl_xor(ss, 32);
          const float rstd = rsqrtf(ss * (1.0f / 128.0f) + 1e-6f) * (1.0f - lambda_init);
          const int row = b * TPB + qk0 + qg * 32 + qt * 16 + l15;
          bf16_t* dst = Acat + (size_t)row * DM + head * 128;
#pragma unroll
          for (int dt = 0; dt < 8; ++dt) {
            const float* sg = P.a_subln + dt * 16 + quad * 4;
            uint2 w;
            w.x = pack2(o2[qt][dt][0] * rstd * sg[0], o2[qt][dt][1] * rstd * sg[1]);
            w.y = pack2(o2[qt][dt][2] * rstd * sg[2], o2[qt][dt][3] * rstd * sg[3]);
            *(uint2*)(dst + dt * 16 + quad * 4) = w;
          }
        }
      }
      continue;
    }
    {
      attn_unit<2, 8, 0, false>(AQ + (size_t)(b * TPB + qk0) * 512 + head * 128, 512, AK + (size_t)(b * TPB) * 512 + head * 128, 512,
                                AVT + (size_t)(b * 4 + head) * 128 * TPB, 256, nseg, qk0, nullptr, 0, 0, 0.f, o, m, l, smem);
    }

    const float i0 = 1.0f / l[0], i1 = lam / l[1];
    float ss = 0.f;
#pragma unroll
    for (int dt = 0; dt < 8; ++dt)
#pragma unroll
      for (int e = 0; e < 4; ++e) {
        const float v = o[0][dt][e] * i0 - o[1][dt][e] * i1;
        o[0][dt][e] = v;
        ss += v * v;
      }
    ss += __shfl_xor(ss, 16);
    ss += __shfl_xor(ss, 32);
    const float rstd = rsqrtf(ss * (1.0f / 128.0f) + 1e-6f) * (1.0f - lambda_init);
    const int row = b * TPB + qk0 + wave * 16 + l15;
    bf16_t* dst = Acat + (size_t)row * DM + head * 128;
#pragma unroll
    for (int dt = 0; dt < 8; ++dt) {
      const float* sg = P.a_subln + dt * 16 + quad * 4;
      uint2 w;
      w.x = pack2(o[0][dt][0] * rstd * sg[0], o[0][dt][1] * rstd * sg[1]);
      w.y = pack2(o[0][dt][2] * rstd * sg[2], o[0][dt][3] * rstd * sg[3]);
      *(uint2*)(dst + dt * 16 + quad * 4) = w;
    }
  }
  for (int u = blockIdx.x; u < 4160; u += gridDim.x) {
    const int b = u / 2080, r = u - b * 2080, qh = r / 260, qb = r - qh * 260;
    const int g = qh >> 2;
    const int qk0 = qb * 64;
    int seg_lo = 256, nseg = 0;
    if (qb >= 4) {
      int lo = qk0 - 128, hi = qk0 + 128;
      if (lo < 256) lo = 256;
      if (hi > TPB - 64) hi = TPB - 64;
      seg_lo = lo;
      nseg = (hi - lo) / 64 + 1;
    }
    f32x4 o[1][4];
    float m[1], l[1];
    attn_unit<1, 4, 1, false>(BQ + (size_t)(b * TPB + qk0) * 512 + qh * 64, 512, BK + (size_t)(b * TPB) * 128 + g * 64, 128,
                              BVT + (size_t)(b * 2 + g) * 64 * TPB, seg_lo, nseg, qk0, nullptr, 0, 0, 0.f, o, m, l, smem);
    const float lt = l[0] + fexp2(P.b_sink[qh] * LOG2E - m[0]);
    const float inv = 1.0f / lt;
    const int row = b * TPB + qk0 + wave * 16 + l15;
    bf16_t* dst = Acat + (size_t)row * DM + 512 + qh * 64;
#pragma unroll
    for (int dt = 0; dt < 4; ++dt) {
      uint2 w;
      w.x = pack2(o[0][dt][0] * inv, o[0][dt][1] * inv);
      w.y = pack2(o[0][dt][2] * inv, o[0][dt][3] * inv);
      *(uint2*)(dst + dt * 16 + quad * 4) = w;
    }
  }
}

__device__ __forceinline__ void phase_na(const Params& P, char* smem) {
  char* ws = P.ws;
  const bf16_t* CQ = (const bf16_t*)(ws + OFF_CQ);
  const bf16_t* CK = (const bf16_t*)(ws + OFF_CK);
  const bf16_t* CVT = (const bf16_t*)(ws + OFF_CVT);
  bf16_t* Acat = (bf16_t*)(ws + OFF_A);
  float* s_rpb = (float*)(smem + 40960);
  const int lane = threadIdx.x & 63, wave = threadIdx.x >> 6, l15 = lane & 15, quad = lane >> 4;
  for (int u = blockIdx.x; u < 4096; u += gridDim.x) {
    const int b = u >> 11, h = (u >> 8) & 7, gi = u & 255;
    const int r0 = min(max(gi - 4, 0), 248);
    __syncthreads();
    for (int e = threadIdx.x; e < 465; e += 256) s_rpb[e] = P.c_rpb[h * 465 + e] * LOG2E;
    __syncthreads();
    const int qk0 = 256 + gi * 64;
    f32x4 o[1][4];
    float m[1], l[1];
    attn_unit<1, 4, 2, false>(CQ + (size_t)(b * TPB + qk0) * 512 + h * 64, 512, CK + (size_t)(b * TPB) * 512 + h * 64, 512,
                              CVT + (size_t)(b * 8 + h) * 64 * TPB, 256 + r0 * 64, 8, qk0, s_rpb, gi, r0, 0.f, o, m, l, smem);
    const float inv = 1.0f / l[0];
    const int row = b * TPB + qk0 + wave * 16 + l15;
    bf16_t* dst = Acat + (size_t)row * DM + h * 64;
#pragma unroll
    for (int dt = 0; dt < 4; ++dt) {
      uint2 w;
      w.x = pack2(o[0][dt][0] * inv, o[0][dt][1] * inv);
      w.y = pack2(o[0][dt][2] * inv, o[0][dt][3] * inv);
      *(uint2*)(dst + dt * 16 + quad * 4) = w;
    }
  }
}

__device__ __forceinline__ void phase_norm(const float* lat_src, const float* ctx_src, const float* gain, const float* modl,
                                           int sh_off, int sc_off, bf16_t* A, bool lat_only) {
  const int lane = threadIdx.x & 63, wave = threadIdx.x >> 6;
  const int total = lat_only ? 32768 : MROWS;
  for (int idx0 = (blockIdx.x * 4 + wave) * 2; idx0 < total; idx0 += gridDim.x * 8) {
    float4 xv[2][4];
    const float* md[2];
    int rowi[2];
#pragma unroll
    for (int u = 0; u < 2; ++u) {
      const int idx = idx0 + u;
      const int row = lat_only ? ((idx >> 14) * TPB + 256 + (idx & 16383)) : idx;
      const int b = row / TPB, kidx = row - b * TPB;
      const bool isc = kidx < 256;
      const float* src = isc ? ctx_src + (size_t)(b * 256 + kidx) * DM : lat_src + (size_t)(b * 16384 + kidx - 256) * DM;
      md[u] = modl + (isc ? 2 : b) * 6144;
      rowi[u] = row;
#pragma unroll
      for (int i = 0; i < 4; ++i) xv[u][i] = *(const float4*)(src + i * 256 + lane * 4);
    }
#pragma unroll
    for (int u = 0; u < 2; ++u) {
      float ss = 0.f;
#pragma unroll
      for (int i = 0; i < 4; ++i) ss += xv[u][i].x * xv[u][i].x + xv[u][i].y * xv[u][i].y + xv[u][i].z * xv[u][i].z + xv[u][i].w * xv[u][i].w;
      ss = wave_sum(ss);
      const float rstd = rsqrtf(ss * (1.0f / 1024.0f) + 1e-6f);
#pragma unroll
      for (int i = 0; i < 4; ++i) {
        const int c = i * 256 + lane * 4;
        const float4 g = *(const float4*)(gain + c);
        const float4 sh = *(const float4*)(md[u] + sh_off + c);
        const float4 sc = *(const float4*)(md[u] + sc_off + c);
        uint2 w;
        w.x = pack2(xv[u][i].x * rstd * g.x * (1.f + sc.x) + sh.x, xv[u][i].y * rstd * g.y * (1.f + sc.y) + sh.y);
        w.y = pack2(xv[u][i].z * rstd * g.z * (1.f + sc.z) + sh.z, xv[u][i].w * rstd * g.w * (1.f + sc.w) + sh.w);
        *(uint2*)(A + (size_t)rowi[u] * DM + c) = w;
      }
    }
  }
}

__device__ __forceinline__ void conv_tile(const float* __restrict__ W, int K, int N, int Npad, bf16_t* __restrict__ dst, int mode,
                          int kt, int nt, char* smem) {
  float* T = (float*)smem;
  const int tid = threadIdx.x;
  const int k0 = kt * 64, n0 = nt * 64;
  __syncthreads();
  {
    const int r = tid >> 4, c4 = (tid & 15) * 4;
#pragma unroll
    for (int i = 0; i < 4; ++i) {
      const int k = r + 16 * i, n = n0 + c4;
      float4 v = make_float4(0.f, 0.f, 0.f, 0.f);
      if (n < N) v = *(const float4*)(W + (size_t)(k0 + k) * N + n);
      T[k * 65 + c4 + 0] = v.x;
      T[k * 65 + c4 + 1] = v.y;
      T[k * 65 + c4 + 2] = v.z;
      T[k * 65 + c4 + 3] = v.w;
    }
  }
  __syncthreads();
  {
    const int n = tid >> 2, ks = (tid & 3) * 16;
    const int gn = n0 + n;
    if (gn < Npad) {
      const int drow = mode == 0 ? gn : ((gn >> 5) * 64 + (gn & 31) + (mode == 2 ? 32 : 0));
      uint32_t w[8];
#pragma unroll
      for (int q = 0; q < 8; ++q) w[q] = pack2(T[(ks + 2 * q) * 65 + n], T[(ks + 2 * q + 1) * 65 + n]);
      uint4* d = (uint4*)(dst + (size_t)drow * K + k0 + ks);
      d[0] = make_uint4(w[0], w[1], w[2], w[3]);
      d[1] = make_uint4(w[4], w[5], w[6], w[7]);
    }
  }
}

__device__ __forceinline__ void phase_conv(const Params& P, int layer, char* smem, int part, int rank, int nrank) {
  char* ws = P.ws;
  const float* w_in = layer == 0 ? P.ab_w_in : P.cd_w_in;
  const int n_in = layer == 0 ? 2304 : 3296;
  const int np_in = layer == 0 ? 2304 : 3328;
  const int nt_in = np_in / 64;
  const float* w_out = layer == 0 ? P.ab_w_out : P.cd_w_out;
  const int t_in = 16 * nt_in;
  const int t_lo = part == 2 ? t_in : 0;
  const int total = part == 1 ? t_in : t_in + 256 + 3 * 704;
  for (int t = t_lo + rank; t < total; t += nrank) {
    if (t < t_in) {
      conv_tile(w_in, 1024, n_in, np_in, (bf16_t*)(ws + OFF_WIN), 0, t / nt_in, t % nt_in, smem);
    } else if (t < t_in + 256) {
      const int q = t - t_in;
      conv_tile(w_out, 1024, 1024, 1024, (bf16_t*)(ws + OFF_WOUT), 0, q >> 4, q & 15, smem);
    } else if (t < t_in + 256 + 704) {
      const int q = t - t_in - 256;
      conv_tile(P.w_gate + (size_t)layer * 1024 * DFF, 1024, DFF, DFF, (bf16_t*)(ws + OFF_WGU), 1, q / 44, q % 44, smem);
    } else if (t < t_in + 256 + 1408) {
      const int q = t - t_in - 256 - 704;
      conv_tile(P.w_up + (size_t)layer * 1024 * DFF, 1024, DFF, DFF, (bf16_t*)(ws + OFF_WGU), 2, q / 44, q % 44, smem);
    } else {
      const int q = t - t_in - 256 - 1408;
      conv_tile(P.w_down + (size_t)layer * DFF * 1024, DFF, 1024, 1024, (bf16_t*)(ws + OFF_WDN), 0, q >> 4, q & 15, smem);
    }
  }
}

__device__ __forceinline__ void phase_adaln(const Params& P, char* smem) {
  float* sc = (float*)smem;
  float* red = sc + 3 * 1024;
  float* mod = (float*)(P.ws + OFF_MOD);
  const int tid = threadIdx.x;
  for (int it = (int)gridDim.x - 1 - (int)blockIdx.x; it < 384; it += gridDim.x) {
    const int layer = it / 192, n0 = (it % 192) * 32;
    __syncthreads();
    for (int e = tid; e < 3072; e += 256) {
      const int i = e >> 10, k = e & 1023;
      const float v = i < 2 ? P.c[i * 1024 + k] : P.c_ctx[k];
      sc[e] = v / (1.0f + __expf(-v));
    }
    __syncthreads();
    const int kg = tid >> 5, col = tid & 31;
    const float* w = P.ada_w + (size_t)layer * 1024 * 6144 + n0 + col;
    float a0 = 0.f, a1 = 0.f, a2 = 0.f;
#pragma unroll 16
    for (int k = kg * 128; k < kg * 128 + 128; ++k) {
      const float wv = w[(size_t)k * 6144];
      a0 += sc[k] * wv;
      a1 += sc[1024 + k] * wv;
      a2 += sc[2048 + k] * wv;
    }
    red[(kg * 32 + col) * 3 + 0] = a0;
    red[(kg * 32 + col) * 3 + 1] = a1;
    red[(kg * 32 + col) * 3 + 2] = a2;
    __syncthreads();
    if (tid < 96) {
      const int i = tid >> 5, cl = tid & 31;
      float sacc = P.ada_b[layer * 6144 + n0 + cl];
#pragma unroll
      for (int g = 0; g < 8; ++g) sacc += red[(g * 32 + cl) * 3 + i];
      mod[(layer * 3 + i) * 6144 + n0 + cl] = sacc;
    }
  }
  if (blockIdx.x == gridDim.x - 1) {
    float* rope = (float*)(P.ws + OFF_ROPE);
    for (int e = tid; e < 4096; e += 256) {
      const int p = e >> 4, f = e & 15;
      const float freq = powf(10000.0f, -(float)(2 * f) / 32.0f);
      const float ang = (float)p * freq;
      rope[e * 2] = cosf(ang);
      rope[e * 2 + 1] = sinf(ang);
    }
    if (tid < 64) {
      float p0 = P.a_lambda[tid] * P.a_lambda[64 + tid];
      float p1 = P.a_lambda[128 + tid] * P.a_lambda[192 + tid];
      p0 = wave_sum(p0);
      p1 = wave_sum(p1);
      float gq = fabsf(P.a_qn[tid]), gk = fabsf(P.a_kn[tid]);
#pragma unroll
      for (int o = 32; o >= 1; o >>= 1) {
        gq = fmaxf(gq, __shfl_xor(gq, o));
        gk = fmaxf(gk, __shfl_xor(gk, o));
      }
      if (tid == 0) {
        ((float*)(P.ws + OFF_LAM))[0] = expf(p0) - expf(p1) + 0.2f;
        ((float*)(P.ws + OFF_LAM))[1] = 8.0f * gq * gk * LOG2E * 1.001f + 0.01f;
      }
    }
  }
}

__device__ __forceinline__ float dppf8(float x, const int sel) {
  const int xi = __float_as_int(x);
  int r;
  if (sel == 0) r = __builtin_amdgcn_update_dpp(0, xi, 0xB1, 0xF, 0xF, true);
  else if (sel == 1) r = __builtin_amdgcn_update_dpp(0, xi, 0x4E, 0xF, 0xF, true);
  else r = __builtin_amdgcn_update_dpp(0, xi, 0x141, 0xF, 0xF, true);
  return __int_as_float(r);
}
__device__ __forceinline__ void phase_lora_conv(const Params& P) {
  bf16_t* WL = (bf16_t*)(P.ws + OFF_WL);
  if (threadIdx.x < 224) {
    const int cl = threadIdx.x / 28, kg = threadIdx.x - cl * 28;
    for (int cb = blockIdx.x; cb < 64; cb += gridDim.x) {
      const int c = cb * 8 + cl;
      float v[8];
#pragma unroll
      for (int q = 0; q < 8; ++q) {
        const int kk = kg * 8 + q;
        if (kk < 64) v[q] = P.d_w2[(size_t)kk * 512 + c];
        else if (kk < 128) v[q] = P.d_a2[(size_t)(kk - 64) * 512 + c];
        else v[q] = P.d_g2[(size_t)(kk - 128) * 512 + c];
      }
      *(uint4*)(WL + (size_t)c * 224 + kg * 8) = make_uint4(pack2(v[0], v[1]), pack2(v[2], v[3]), pack2(v[4], v[5]), pack2(v[6], v[7]));
    }
  }
}

#define PREP_T 32
#define SLS 232
__device__ __forceinline__ void phase_prep(const Params& P, char* smem) {
  char* ws = P.ws;
  bf16_t* sL = (bf16_t*)smem;
  const bf16_t* RAW = (const bf16_t*)(ws + OFF_RAW);
  const float* LORA = (const float*)(ws + OFF_LORA);
  const bf16_t* WL = (const bf16_t*)(ws + OFF_WL);
  bf16_t* XR = (bf16_t*)(ws + OFF_XR);
  bf16_t* XK = (bf16_t*)(ws + OFF_XK);
  bf16_t* XV = (bf16_t*)(ws + OFF_XV);
  bf16_t* KK = (bf16_t*)(ws + OFF_KK);
  bf16_t* DP = (bf16_t*)(ws + OFF_DP);
  bf16_t* AZ = (bf16_t*)(ws + OFF_AZ);
  bf16_t* Acat = (bf16_t*)(ws + OFF_A);
  const float* mu = P.d_mu;
  const int tid = threadIdx.x, lane = tid & 63, wave = tid >> 6, l15 = lane & 15, quad = lane >> 4;
  for (int tt = blockIdx.x; tt < MROWS / PREP_T; tt += gridDim.x) {
    const int row0 = tt * PREP_T;
    const int b = row0 / TPB, k0 = row0 - b * TPB;
    __syncthreads();
    for (int e = tid; e < PREP_T * 8; e += 256) sL[(e >> 3) * SLS + 224 + (e & 7)] = 0;
#pragma unroll 7
    for (int e = tid; e < PREP_T * 224; e += 256) {
      const int tok = e / 224, j = e - tok * 224;
      const int kidx = k0 + tok, row = row0 + tok;
      const bool hp = (kidx != 0 && kidx != 256), hn = (kidx != 255 && kidx != TPB - 1);
      const float x = LORA[(size_t)row * 224 + j];
      const float xp = hp ? LORA[(size_t)(row - 1) * 224 + j] : 0.f;
      const float xn = hn ? LORA[(size_t)(row + 1) * 224 + j] : 0.f;
      const float xs = x + mu[1536 + j] * (0.5f * (xp + xn) - x);
      sL[tok * SLS + j] = f2bf(j < 64 ? (1.0f - 2.0f * __builtin_amdgcn_rcpf(__expf(2.0f * xs) + 1.0f)) : (j < 128 ? xs : sigmoidf_(xs)));
    }
    __syncthreads();
    for (int nt = 0; nt < 8; ++nt) {
      const int n0 = wave * 128 + nt * 16;
      bf16x8 wf[7];
#pragma unroll
      for (int kb = 0; kb < 7; ++kb) wf[kb] = *(const bf16x8*)(WL + (size_t)(n0 + l15) * 224 + kb * 32 + quad * 8);
      const int c4 = n0 + quad * 4;
      const float4 w00 = *(const float4*)(P.d_w0 + c4), w01 = *(const float4*)(P.d_w0 + 512 + c4);
      const float4 a00 = *(const float4*)(P.d_a0 + c4), a01 = *(const float4*)(P.d_a0 + 512 + c4);
#pragma unroll
      for (int mt = 0; mt < PREP_T / 16; ++mt) {
        bf16x8 af[7];
#pragma unroll
        for (int kb = 0; kb < 7; ++kb) af[kb] = *(const bf16x8*)(sL + (mt * 16 + l15) * SLS + kb * 32 + quad * 8);
        const f32x4 zero = (f32x4){0.f, 0.f, 0.f, 0.f};
        f32x4 aw0 = __builtin_amdgcn_mfma_f32_16x16x32_bf16(wf[0], af[0], zero, 0, 0, 0);
        f32x4 aw1 = __builtin_amdgcn_mfma_f32_16x16x32_bf16(wf[1], af[1], zero, 0, 0, 0);
        f32x4 aa0 = __builtin_amdgcn_mfma_f32_16x16x32_bf16(wf[2], af[2], zero, 0, 0, 0);
        f32x4 aa1 = __builtin_amdgcn_mfma_f32_16x16x32_bf16(wf[3], af[3], zero, 0, 0, 0);
        f32x4 ag = __builtin_amdgcn_mfma_f32_16x16x32_bf16(wf[4], af[4], zero, 0, 0, 0);
        ag = __builtin_amdgcn_mfma_f32_16x16x32_bf16(wf[5], af[5], ag, 0, 0, 0);
        ag = __builtin_amdgcn_mfma_f32_16x16x32_bf16(wf[6], af[6], ag, 0, 0, 0);
        const size_t row = (size_t)(row0 + mt * 16 + l15);
        float dp0[4], dp1[4], az0[4], az1[4];
#pragma unroll
        for (int e = 0; e < 4; ++e) {
          const float wb0 = e == 0 ? w00.x : (e == 1 ? w00.y : (e == 2 ? w00.z : w00.w));
          const float wb1 = e == 0 ? w01.x : (e == 1 ? w01.y : (e == 2 ? w01.z : w01.w));
          const float ab0 = e == 0 ? a00.x : (e == 1 ? a00.y : (e == 2 ? a00.z : a00.w));
          const float ab1 = e == 0 ? a01.x : (e == 1 ? a01.y : (e == 2 ? a01.z : a01.w));
#pragma unroll
          for (int z = 0; z < 2; ++z) {
            const float wv = z == 0 ? wb0 + aw0[e] : wb1 + aw1[e];
            const float ee = 0.60653066f * sigmoidf_(wv);
            const float dpv = 1.0f - __expf(-ee);
            const float av = sigmoidf_(z == 0 ? ab0 + aa0[e] : ab1 + aa1[e]);
            if (z == 0) { dp0[e] = dpv; az0[e] = av; } else { dp1[e] = dpv; az1[e] = av; }
          }
        }
        uint2 w;
        w.x = pack2(dp0[0], dp0[1]); w.y = pack2(dp0[2], dp0[3]);
        *(uint2*)(DP + row * 512 + c4) = w;
        w.x = pack2(dp1[0], dp1[1]); w.y = pack2(dp1[2], dp1[3]);
        *(uint2*)(DP + (SZ512 / 2) + row * 512 + c4) = w;
        w.x = pack2(az0[0], az0[1]); w.y = pack2(az0[2], az0[3]);
        *(uint2*)(AZ + row * 512 + c4) = w;
        w.x = pack2(az1[0], az1[1]); w.y = pack2(az1[2], az1[3]);
        *(uint2*)(AZ + (SZ512 / 2) + row * 512 + c4) = w;
        w.x = pack2(ag[0], ag[1]); w.y = pack2(ag[2], ag[3]);
        *(uint2*)(Acat + row * DM + 512 + c4) = w;
      }
    }
    __syncthreads();
    {
      const int c8 = (tid & 63) * 8, tk = tid >> 6;
      float mr[8], mk[8], mv[8], kc[8];
#pragma unroll
      for (int q = 0; q < 8; ++q) { mr[q] = mu[c8 + q]; mk[q] = mu[512 + c8 + q]; mv[q] = mu[1024 + c8 + q]; kc[q] = P.d_k_k[c8 + q]; }
#pragma unroll 2
      for (int pass = 0; pass < PREP_T / 4; ++pass) {
        const int k = pass * 4 + tk;
        const int kidx = k0 + k;
        const size_t row = (size_t)(row0 + k);
        const bool hp = (kidx != 0 && kidx != 256), hn = (kidx != 255 && kidx != TPB - 1);
        uint4 xc[3], xpv[3], xnv[3];
#pragma unroll
        for (int q = 0; q < 3; ++q) {
          xc[q] = *(const uint4*)(RAW + row * 1536 + q * 512 + c8);
          xpv[q] = hp ? *(const uint4*)(RAW + (row - 1) * 1536 + q * 512 + c8) : make_uint4(0u, 0u, 0u, 0u);
          xnv[q] = hn ? *(const uint4*)(RAW + (row + 1) * 1536 + q * 512 + c8) : make_uint4(0u, 0u, 0u, 0u);
        }
        float xs[3][8];
#pragma unroll
        for (int q = 0; q < 3; ++q) {
          const uint32_t cw[4] = {xc[q].x, xc[q].y, xc[q].z, xc[q].w};
          const uint32_t pw[4] = {xpv[q].x, xpv[q].y, xpv[q].z, xpv[q].w};
          const uint32_t nw[4] = {xnv[q].x, xnv[q].y, xnv[q].z, xnv[q].w};
#pragma unroll
          for (int w = 0; w < 4; ++w) {
            const float x0 = __uint_as_float(cw[w] << 16), x1 = __uint_as_float(cw[w] & 0xffff0000u);
            const float p0 = __uint_as_float(pw[w] << 16), p1 = __uint_as_float(pw[w] & 0xffff0000u);
            const float n0 = __uint_as_float(nw[w] << 16), n1 = __uint_as_float(nw[w] & 0xffff0000u);
            const float m0 = q == 0 ? mr[2 * w] : (q == 1 ? mk[2 * w] : mv[2 * w]);
            const float m1 = q == 0 ? mr[2 * w + 1] : (q == 1 ? mk[2 * w + 1] : mv[2 * w + 1]);
            xs[q][2 * w] = x0 + m0 * (0.5f * (p0 + n0) - x0);
            xs[q][2 * w + 1] = x1 + m1 * (0.5f * (p1 + n1) - x1);
          }
        }
        *(uint4*)(XR + row * 512 + c8) = make_uint4(pack2(xs[0][0], xs[0][1]), pack2(xs[0][2], xs[0][3]), pack2(xs[0][4], xs[0][5]), pack2(xs[0][6], xs[0][7]));
        *(uint4*)(XK + row * 512 + c8) = make_uint4(pack2(xs[1][0], xs[1][1]), pack2(xs[1][2], xs[1][3]), pack2(xs[1][4], xs[1][5]), pack2(xs[1][6], xs[1][7]));
        *(uint4*)(XV + row * 512 + c8) = make_uint4(pack2(xs[2][0], xs[2][1]), pack2(xs[2][2], xs[2][3]), pack2(xs[2][4], xs[2][5]), pack2(xs[2][6], xs[2][7]));
        float kv[8], ss = 0.f;
#pragma unroll
        for (int q = 0; q < 8; ++q) { kv[q] = xs[1][q] * kc[q]; ss += kv[q] * kv[q]; }
        ss += dppf8(ss, 0);
        ss += dppf8(ss, 1);
        ss += dppf8(ss, 2);
        const float inv = 1.0f / fmaxf(sqrtf(ss), 1e-12f);
        *(uint4*)(KK + row * 512 + c8) = make_uint4(pack2(kv[0] * inv, kv[1] * inv), pack2(kv[2] * inv, kv[3] * inv),
                                                   pack2(kv[4] * inv, kv[5] * inv), pack2(kv[6] * inv, kv[7] * inv));
      }
    }
  }
}

__device__ __forceinline__ float dppf(float x, const int ctrl_sel) {
  int xi = __float_as_int(x), r;
  if (ctrl_sel == 0) r = __builtin_amdgcn_update_dpp(0, xi, 0xB1, 0xF, 0xF, true);
  else if (ctrl_sel == 1) r = __builtin_amdgcn_update_dpp(0, xi, 0x4E, 0xF, 0xF, true);
  else if (ctrl_sel == 2) r = __builtin_amdgcn_update_dpp(0, xi, 0x141, 0xF, 0xF, true);
  else r = __builtin_amdgcn_update_dpp(0, xi, 0x140, 0xF, 0xF, true);
  return __int_as_float(r);
}
__device__ __forceinline__ float red16(float x) {
  x += dppf(x, 0);
  x += dppf(x, 1);
  x += dppf(x, 2);
  x += dppf(x, 3);
  return x;
}

__device__ __forceinline__ void phase_scan(const Params& P, char* smem) {
  const int kloc = blockIdx.x >> 3;
  if ((kloc & 1) || kloc >= 32) return;
  const int widx = (kloc >> 1) * 8 + (blockIdx.x & 7);
  char* ws = P.ws;
  const int chain = widx >> 2, rg = widx & 3;
  const int z = chain >> 4, b = (chain >> 3) & 1, h = chain & 7;
  const bf16_t* XR = (const bf16_t*)(ws + OFF_XR);
  const bf16_t* XK = (const bf16_t*)(ws + OFF_XK);
  const bf16_t* XV = (const bf16_t*)(ws + OFF_XV);
  const bf16_t* KK = (const bf16_t*)(ws + OFF_KK);
  const bf16_t* DP = (const bf16_t*)(ws + OFF_DP) + (size_t)z * (SZ512 / 2);
  const bf16_t* AZ = (const bf16_t*)(ws + OFF_AZ) + (size_t)z * (SZ512 / 2);
  bf16_t* YZ = (bf16_t*)(ws + OFF_YZ) + (size_t)z * (SZ512 / 2);
  float* buf = (float*)smem;
  const int tid = threadIdx.x;
  const int rowl = tid >> 4, kq = tid & 15;
  const int vrow = rg * 16 + rowl;
  const int sl = tid >> 4, k4 = (tid & 15) * 4;
  float ka[4];
#pragma unroll
  for (int i = 0; i < 4; ++i) ka[i] = P.d_k_a[h * 64 + k4 + i];
  f32x2 S01 = (f32x2){0.f, 0.f}, S23 = (f32x2){0.f, 0.f};
  uint2 g_r[2], g_k[2], g_v[2], g_kk[2], g_dp[2], g_az[2];
  auto kidx_of = [&](int n) { return z == 0 ? n : (n < 256 ? 255 - n : 16895 - n); };
#define SCAN_GLOAD(ci_)                                                              \
  _Pragma("unroll") for (int hh = 0; hh < 2; ++hh) {                                 \
    const int kidx = kidx_of((ci_) * 32 + hh * 16 + sl);                             \
    const size_t off = (size_t)(b * TPB + kidx) * 512 + h * 64 + k4;                 \
    g_r[hh] = *(const uint2*)(XR + off);                                             \
    g_k[hh] = *(const uint2*)(XK + off);                                             \
    g_v[hh] = *(const uint2*)(XV + off);                                             \
    g_kk[hh] = *(const uint2*)(KK + off);                                            \
    g_dp[hh] = *(const uint2*)(DP + off);                                            \
    g_az[hh] = *(const uint2*)(AZ + off);                                            \
  }
  SCAN_GLOAD(0)
  const int nchunks = TPB / 32;
  for (int ci = 0; ci < nchunks; ++ci) {
#pragma unroll
    for (int hh = 0; hh < 2; ++hh) {
      float r[4], k[4], v[4], kk[4], dp[4], az[4];
      r[0] = __uint_as_float(g_r[hh].x << 16); r[1] = __uint_as_float(g_r[hh].x & 0xffff0000u);
      r[2] = __uint_as_float(g_r[hh].y << 16); r[3] = __uint_as_float(g_r[hh].y & 0xffff0000u);
      k[0] = __uint_as_float(g_k[hh].x << 16); k[1] = __uint_as_float(g_k[hh].x & 0xffff0000u);
      k[2] = __uint_as_float(g_k[hh].y << 16); k[3] = __uint_as_float(g_k[hh].y & 0xffff0000u);
      v[0] = __uint_as_float(g_v[hh].x << 16); v[1] = __uint_as_float(g_v[hh].x & 0xffff0000u);
      v[2] = __uint_as_float(g_v[hh].y << 16); v[3] = __uint_as_float(g_v[hh].y & 0xffff0000u);
      kk[0] = __uint_as_float(g_kk[hh].x << 16); kk[1] = __uint_as_float(g_kk[hh].x & 0xffff0000u);
      kk[2] = __uint_as_float(g_kk[hh].y << 16); kk[3] = __uint_as_float(g_kk[hh].y & 0xffff0000u);
      dp[0] = __uint_as_float(g_dp[hh].x << 16); dp[1] = __uint_as_float(g_dp[hh].x & 0xffff0000u);
      dp[2] = __uint_as_float(g_dp[hh].y << 16); dp[3] = __uint_as_float(g_dp[hh].y & 0xffff0000u);
      az[0] = __uint_as_float(g_az[hh].x << 16); az[1] = __uint_as_float(g_az[hh].x & 0xffff0000u);
      az[2] = __uint_as_float(g_az[hh].y << 16); az[3] = __uint_as_float(g_az[hh].y & 0xffff0000u);
      float* bp = buf + (hh * 16 + sl) * 384 + k4;
      *(float4*)(bp + 0) = make_float4(r[0], r[1], r[2], r[3]);
      *(float4*)(bp + 64) = make_float4(1.f - dp[0], 1.f - dp[1], 1.f - dp[2], 1.f - dp[3]);
      *(float4*)(bp + 128) = make_float4(k[0] * (1.f + (az[0] - 1.f) * ka[0]), k[1] * (1.f + (az[1] - 1.f) * ka[1]),
                                         k[2] * (1.f + (az[2] - 1.f) * ka[2]), k[3] * (1.f + (az[3] - 1.f) * ka[3]));
      *(float4*)(bp + 192) = make_float4(v[0], v[1], v[2], v[3]);
      *(float4*)(bp + 256) = make_float4(-kk[0], -kk[1], -kk[2], -kk[3]);
      *(float4*)(bp + 320) = make_float4(kk[0] * az[0], kk[1] * az[1], kk[2] * az[2], kk[3] * az[3]);
    }
    __syncthreads();
    if (ci + 1 < nchunks) { SCAN_GLOAD(ci + 1) }
    float ykeep0 = 0.f, ykeep1 = 0.f;
    f32x4 Lr[2][2], Lw[2][2], Lk[2][2], La[2][2], Lb[2][2];
    float Lv[2][2];
#define SCAN_LOADB(j_, slot_)                                               \
  _Pragma("unroll") for (int u = 0; u < 2; ++u) {                           \
    const float* bp = buf + ((j_) * 2 + u) * 384 + kq * 4;                  \
    Lr[slot_][u] = *(const f32x4*)(bp + 0);                                 \
    Lw[slot_][u] = *(const f32x4*)(bp + 64);                                \
    Lk[slot_][u] = *(const f32x4*)(bp + 128);                               \
    Lv[slot_][u] = buf[((j_) * 2 + u) * 384 + 192 + vrow];                  \
    La[slot_][u] = *(const f32x4*)(bp + 256);                               \
    Lb[slot_][u] = *(const f32x4*)(bp + 320);                               \
  }
    SCAN_LOADB(0, 0)
    float yprev = 0.f;
#pragma unroll
    for (int j = 0; j < 16; ++j) {
      if (j + 1 < 16) {
        SCAN_LOADB(j + 1, (j + 1) & 1)
      }
      __builtin_amdgcn_sched_barrier(0);
#pragma unroll
      for (int u = 0; u < 2; ++u) {
        const int sl2 = j & 1;
        const int st = j * 2 + u;
        const f32x4 a4 = La[sl2][u], b4 = Lb[sl2][u], w4 = Lw[sl2][u], kd = Lk[sl2][u], r4 = Lr[sl2][u];
        const float vv = Lv[sl2][u];
        f32x2 p = S01 * a4.xy;
        p = S23 * a4.zw + p;
        float sa = p.x + p.y;
        sa += dppf(sa, 0); yprev += dppf(yprev, 0);
        sa += dppf(sa, 1); yprev += dppf(yprev, 1);
        sa += dppf(sa, 2); yprev += dppf(yprev, 2);
        sa += dppf(sa, 3); yprev += dppf(yprev, 3);
        if (st >= 1 && st <= 16) ykeep0 = (kq == st - 1) ? yprev : ykeep0;
        if (st >= 17) ykeep1 = (kq == st - 17) ? yprev : ykeep1;
        const f32x2 sa2 = (f32x2){sa, sa}, vv2 = (f32x2){vv, vv};
        const f32x2 t01 = sa2 * b4.xy + vv2 * kd.xy;
        const f32x2 t23 = sa2 * b4.zw + vv2 * kd.zw;
        S01 = S01 * w4.xy + t01;
        S23 = S23 * w4.zw + t23;
        f32x2 q = S01 * r4.xy;
        q = S23 * r4.zw + q;
        yprev = q.x + q.y;
      }
    }
    yprev = red16(yprev);
    ykeep1 = (kq == 15) ? yprev : ykeep1;
    {
      const int kidx0 = kidx_of(ci * 32 + kq), kidx1 = kidx_of(ci * 32 + 16 + kq);
      YZ[(size_t)(b * TPB + kidx0) * 512 + h * 64 + rg * 16 + rowl] = f2bf(ykeep0);
      YZ[(size_t)(b * TPB + kidx1) * 512 + h * 64 + rg * 16 + rowl] = f2bf(ykeep1);
    }
    __syncthreads();
  }
}

__device__ __forceinline__ float red8(float x) {
  x += dppf8(x, 0);
  x += dppf8(x, 1);
  x += dppf8(x, 2);
  return x;
}
__device__ __forceinline__ void unpack8(const uint4 g, float (&o)[8]) {
  o[0] = __uint_as_float(g.x << 16); o[1] = __uint_as_float(g.x & 0xffff0000u);
  o[2] = __uint_as_float(g.y << 16); o[3] = __uint_as_float(g.y & 0xffff0000u);
  o[4] = __uint_as_float(g.z << 16); o[5] = __uint_as_float(g.z & 0xffff0000u);
  o[6] = __uint_as_float(g.w << 16); o[7] = __uint_as_float(g.w & 0xffff0000u);
}
__device__ __forceinline__ void phase_rwkv_out(const Params& P) {
  char* ws = P.ws;
  const bf16_t* XR = (const bf16_t*)(ws + OFF_XR);
  const bf16_t* XK = (const bf16_t*)(ws + OFF_XK);
  const bf16_t* XV = (const bf16_t*)(ws + OFF_XV);
  const bf16_t* AZ = (const bf16_t*)(ws + OFF_AZ);
  const bf16_t* YZ = (const bf16_t*)(ws + OFF_YZ);
  bf16_t* Acat = (bf16_t*)(ws + OFF_A);
  const int lane = threadIdx.x & 63, wave = threadIdx.x >> 6;
  const int c8 = lane * 8;
  float lw[8], lb[8], kav[8], rkv[8];
#pragma unroll
  for (int q = 0; q < 8; ++q) { lw[q] = P.d_ln_w[c8 + q]; lb[q] = P.d_ln_b[c8 + q]; kav[q] = P.d_k_a[c8 + q]; rkv[q] = P.d_r_k[c8 + q]; }
#pragma unroll 2
  for (int idx = blockIdx.x * 4 + wave; idx < 32768; idx += gridDim.x * 4) {
    const size_t row = (size_t)((idx >> 14) * TPB + 256 + (idx & 16383));
    const size_t off = row * 512 + c8;
    const uint4 u_y0 = *(const uint4*)(YZ + off), u_y1 = *(const uint4*)(YZ + (SZ512 / 2) + off);
    const uint4 u_r = *(const uint4*)(XR + off), u_k = *(const uint4*)(XK + off), u_v = *(const uint4*)(XV + off);
    const uint4 u_a0 = *(const uint4*)(AZ + off), u_a1 = *(const uint4*)(AZ + (SZ512 / 2) + off);
    const uint4 u_g = *(const uint4*)(Acat + row * DM + 512 + c8);
    float y0[8], y1[8], rr[8], kk_[8], vv[8], a0[8], a1[8], gg[8];
    unpack8(u_y0, y0); unpack8(u_y1, y1); unpack8(u_r, rr); unpack8(u_k, kk_); unpack8(u_v, vv);
    unpack8(u_a0, a0); unpack8(u_a1, a1); unpack8(u_g, gg);
    float y[8], sy = 0.f, sd = 0.f;
#pragma unroll
    for (int q = 0; q < 8; ++q) {
      y[q] = y0[q] + y1[q];
      sy += y[q];
      const float kd = kk_[q] * (1.f + (a0[q] - 1.f) * kav[q]) + kk_[q] * (1.f + (a1[q] - 1.f) * kav[q]);
      sd += rr[q] * kd * rkv[q];
    }
    const float mean = red8(sy) * (1.0f / 64.0f);
    const float sdot = red8(sd);
    float sv = 0.f;
#pragma unroll
    for (int q = 0; q < 8; ++q) { y[q] -= mean; sv += y[q] * y[q]; }
    const float rstd = rsqrtf(red8(sv) * (1.0f / 64.0f) + 64e-5f);
    float o[8];
#pragma unroll
    for (int q = 0; q < 8; ++q) o[q] = (y[q] * rstd * lw[q] + lb[q] + sdot * vv[q]) * gg[q];
    *(uint4*)(Acat + row * DM + 512 + c8) = make_uint4(pack2(o[0], o[1]), pack2(o[2], o[3]), pack2(o[4], o[5]), pack2(o[6], o[7]));
  }
}

#define XB_TMO      128
#define XB_XCNT(j)  (256  + 64 * (j))
#define XB_XSUB(j)  (1280 + 64 * (j))
#define XB_XGEN(j)  (2304 + 64 * (j))
#define XB_TOP      3328
#define XB_TOPGEN   3392
#define XCD_BAR_WORDS 3456
#define XB_SPIN_CAP (1u << 22)
#define LAS __attribute__((address_space(3)))
__device__ __forceinline__ unsigned xb_ld(unsigned* p) { return __hip_atomic_load(p, __ATOMIC_RELAXED, __HIP_MEMORY_SCOPE_AGENT); }
__device__ __forceinline__ unsigned xb_add(unsigned* p, unsigned v) { return __hip_atomic_fetch_add(p, v, __ATOMIC_RELAXED, __HIP_MEMORY_SCOPE_AGENT); }
__device__ __forceinline__ unsigned xb_xcc_id() { return (unsigned)__builtin_amdgcn_s_getreg((3 << 11) | 20) & 0xFu; }
#define XB_SPIN(cond, bar) do { unsigned _sp = 0; while (cond) { __builtin_amdgcn_s_sleep(1); \
    if ((++_sp & 255u) == 0u) { if (xb_ld(&(bar)[XB_TMO])) break; if (_sp > XB_SPIN_CAP) { atomicAdd(&(bar)[XB_TMO], 1u); break; } } } } while (0)
struct XcdBarrier { unsigned* bar; unsigned x; volatile LAS unsigned* st; };
__device__ __forceinline__ XcdBarrier xcd_barrier_post(unsigned* bar, volatile LAS unsigned* st) {
  XcdBarrier b; b.bar = bar; b.x = xb_xcc_id(); b.st = st;
  if (threadIdx.x == 0) (void)xb_add(&bar[XB_XCNT(b.x)], 1u);
  return b;
}
__device__ __forceinline__ void xcd_barrier_complete(unsigned* bar, unsigned x, unsigned& nloc, unsigned& nx) {
  const unsigned G = gridDim.x * gridDim.y * gridDim.z;
  unsigned sum, cnt, mine, sp = 0u;
  for (;;) {
    sum = 0u; cnt = 0u; mine = 0u;
#pragma unroll
    for (unsigned j = 0; j < 16; ++j) { const unsigned c = xb_ld(&bar[XB_XCNT(j)]); sum += c; cnt += (c > 0u) ? 1u : 0u; mine = (j == x) ? c : mine; }
    if (sum == G) break;
    __builtin_amdgcn_s_sleep(1);
    if ((++sp & 255u) == 0u) { if (xb_ld(&bar[XB_TMO])) break; if (sp > XB_SPIN_CAP) { atomicAdd(&bar[XB_TMO], 1u); break; } }
  }
  nloc = mine > 0u ? mine : 1u; nx = cnt > 0u ? cnt : 1u;
}
__device__ __forceinline__ void xcd_barrier(const XcdBarrier& b) {
  asm volatile("s_waitcnt vmcnt(0)" ::: "memory");
  __syncthreads();
  if (threadIdx.x == 0) {
    unsigned* bar = b.bar;
    __builtin_amdgcn_s_waitcnt(0);
    unsigned nloc = b.st[0], nx = b.st[1];
    if (nloc == 0u) { xcd_barrier_complete(bar, b.x, nloc, nx); b.st[0] = nloc; b.st[1] = nx; }
    const unsigned old = xb_add(&bar[XB_XSUB(b.x)], 1u);
    const unsigned gen = old / nloc;
    if (old + 1u == (gen + 1u) * nloc) {
      __builtin_amdgcn_fence(__ATOMIC_RELEASE, "agent");
      asm volatile("s_waitcnt vmcnt(0)" ::: "memory");
      const unsigned og = xb_add(&bar[XB_TOP], 1u);
      const unsigned tg = og / nx;
      if (og + 1u == (tg + 1u) * nx) xb_add(&bar[XB_TOPGEN], 1u);
      else XB_SPIN(xb_ld(&bar[XB_TOPGEN]) == tg, bar);
      __builtin_amdgcn_fence(__ATOMIC_ACQUIRE, "agent");
      xb_add(&bar[XB_XGEN(b.x)], 1u);
      asm volatile("s_waitcnt vmcnt(0)" ::: "memory");
    } else {
      XB_SPIN(xb_ld(&bar[XB_XGEN(b.x)]) == gen, bar);
      __builtin_amdgcn_fence(__ATOMIC_ACQUIRE, "agent");
      asm volatile("s_waitcnt vmcnt(0)" ::: "memory");
    }
  }
  __syncthreads();
}

#define NPHASE 18
__device__ __forceinline__ void run_phase(const Params& P, int ph, char* smem) {
  char* ws = P.ws;
  bf16_t* A = (bf16_t*)(ws + OFF_A);
  float* xctx = (float*)(ws + OFF_XCTX);
  const float* mod0 = (const float*)(ws + OFF_MOD);
  const float* mod1 = mod0 + 3 * 6144;
  const bf16_t* WIN = (const bf16_t*)(ws + OFF_WIN);
  const bf16_t* WOUT = (const bf16_t*)(ws + OFF_WOUT);
  const bf16_t* WGU = (const bf16_t*)(ws + OFF_WGU);
  const bf16_t* WDN = (const bf16_t*)(ws + OFF_WDN);
  bf16_t* ACT = (bf16_t*)(ws + OFF_ACT);
  switch (ph) {
    case 0:
      phase_conv(P, 0, smem, 0, blockIdx.x, gridDim.x);
      phase_adaln(P, smem);
      break;
    case 1:
      phase_norm(P.x, P.ctx, P.norm_mix, mod0, 0, 1024, A, false);
      break;
    case 2: {
      EpiIn0 e;
      e.a_qn = P.a_qn; e.a_kn = P.a_kn; e.b_qn = P.b_qn; e.b_kn = P.b_kn;
      e.rope = (const float*)(ws + OFF_ROPE);
      e.AQ = (bf16_t*)(ws + OFF_AQ); e.AK = (bf16_t*)(ws + OFF_AK); e.AVT = (bf16_t*)(ws + OFF_AVT);
      e.BQ = (bf16_t*)(ws + OFF_BQ); e.BK = (bf16_t*)(ws + OFF_BK); e.BVT = (bf16_t*)(ws + OFF_BVT);
      gemm_phase<false>(A, DM, WIN, 1024, 18, false, e, smem);
    } break;
    case 3:
      phase_attn0(P, smem);
      break;
    case 4: {
      EpiRes e;
      e.lat_src = P.x; e.ctx_src = P.ctx; e.lat_dst = P.out; e.ctx_dst = xctx; e.gate = mod0 + 2048;
      gemm_phase<true>(A, DM, WOUT, 1024, 8, false, e, smem);
    } break;
    case 5:
      phase_norm(P.out, xctx, P.norm_ffn, mod0, 3072, 4096, A, false);
      break;
    case 6: {
      EpiGU e;
      e.ACT = ACT;
      gemm_phase<true>(A, DM, WGU, 1024, 44, false, e, smem);
    } break;
    case 7: {
      EpiRes e;
      e.lat_src = P.out; e.ctx_src = xctx; e.lat_dst = P.out; e.ctx_dst = xctx; e.gate = mod0 + 5120;
      gemm_phase<true>(ACT, DFF, WDN, DFF, 8, false, e, smem);
    } break;
    case 8:
      phase_conv(P, 1, smem, 1, blockIdx.x, gridDim.x);
      phase_lora_conv(P);
      phase_norm(P.out, xctx, P.norm_mix + 1024, mod1, 0, 1024, A, false);
      break;
    case 9: {
      EpiIn1 e;
      e.c_qn = P.c_qn; e.c_kn = P.c_kn;
      e.CQ = (bf16_t*)(ws + OFF_CQ); e.CK = (bf16_t*)(ws + OFF_CK); e.CVT = (bf16_t*)(ws + OFF_CVT);
      e.RAW = (bf16_t*)(ws + OFF_RAW); e.LORA = (float*)(ws + OFF_LORA);
      gemm_phase<false>(A, DM, WIN, 1024, 26, false, e, smem);
    } break;
    case 10:
      phase_na(P, smem);
      break;
    case 11:
      phase_prep(P, smem);
      break;
    case 12: {
      const int kloc = blockIdx.x >> 3;
      const bool is_scan = !((kloc & 1) || kloc >= 32);
      if (is_scan) phase_scan(P, smem);
      else {
        const int kc = kloc < 32 ? kloc : 32;
        phase_conv(P, 1, smem, 2, (int)blockIdx.x - 8 * ((kc + 1) >> 1), (int)gridDim.x - 128);
      }
    } break;
    case 13:
      phase_rwkv_out(P);
      break;
    case 14: {
      EpiRes e;
      e.lat_src = P.out; e.ctx_src = xctx; e.lat_dst = P.out; e.ctx_dst = xctx; e.gate = mod1 + 2048;
      gemm_phase<true>(A, DM, WOUT, 1024, 8, true, e, smem);
    } break;
    case 15:
      phase_norm(P.out, xctx, P.norm_ffn + 1024, mod1, 3072, 4096, A, true);
      break;
    case 16: {
      EpiGU e;
      e.ACT = ACT;
      gemm_phase<true>(A, DM, WGU, 1024, 44, true, e, smem);
    } break;
    case 17: {
      EpiRes e;
      e.lat_src = P.out; e.ctx_src = xctx; e.lat_dst = P.out; e.ctx_dst = xctx; e.gate = mod1 + 5120;
      gemm_phase<true>(ACT, DFF, WDN, DFF, 8, true, e, smem);
    } break;
    default: break;
  }
}

#define SMEM_BYTES 49152

#if MEGA
template <int PH>
__device__ __forceinline__ void run_all(const Params& P, char* smem, cg::grid_group& grid, const XcdBarrier& xb) {
  run_phase(P, PH, smem);
  if constexpr (((DUP_MASK >> PH) & 1) != 0) {
    xcd_barrier(xb);
    run_phase(P, PH, smem);
  }
  if constexpr (PH + 1 < NPHASE) {
    if constexpr (PH == 0) grid.sync(); else xcd_barrier(xb);
    run_all<PH + 1>(P, smem, grid, xb);
  }
}
__global__ void __launch_bounds__(256, 2) fwd_mega(Params P) {
  extern __shared__ __attribute__((aligned(16))) char smem[];
  __shared__ uint4 xb_words;
  cg::grid_group grid = cg::this_grid();
  if (threadIdx.x == 0) xb_words = make_uint4(0u, 0u, 0u, 0u);
  __syncthreads();
  XcdBarrier xb = xcd_barrier_post((unsigned*)(P.ws + OFF_BAR), (volatile LAS unsigned*)&xb_words);
  run_all<0>(P, smem, grid, xb);
}
#else
template <int PH>
__global__ void __launch_bounds__(256, 2) fwd_phase(Params P) {
  extern __shared__ __attribute__((aligned(16))) char smem[];
  run_phase(P, PH, smem);
}
template <int PH>
static void launch_all(const Params& P, hipStream_t stream) {
  fwd_phase<PH><<<512, 256, SMEM_BYTES, stream>>>(P);
  if constexpr (PH + 1 < NPHASE) launch_all<PH + 1>(P, stream);
}
#endif

extern "C" void kernel_launch(void* const* d_in, const int* in_sizes, int n_in, void* d_out, int out_size, void* d_ws,
                              size_t ws_size, hipStream_t stream) {
  if (ws_size < WS_NEEDED) {
    fprintf(stderr, "workspace too small: %zu < %llu\n", ws_size, (unsigned long long)WS_NEEDED);
    return;
  }
  Params P{};
  const float** pp = (const float**)&P;
  for (int i = 0; i < 36; ++i) pp[i] = (const float*)d_in[i];
  P.out = (float*)d_out;
  P.ws = (char*)d_ws;
#if MEGA
  static int grid_blocks = 0;
  if (!grid_blocks) {
    int dev = 0, cus = 0, per_cu = 0;
    hipGetDevice(&dev);
    hipDeviceGetAttribute(&cus, hipDeviceAttributeMultiprocessorCount, dev);
    hipFuncSetAttribute((const void*)fwd_mega, hipFuncAttributeMaxDynamicSharedMemorySize, SMEM_BYTES);
    hipOccupancyMaxActiveBlocksPerMultiprocessor(&per_cu, fwd_mega, 256, SMEM_BYTES);
    if (per_cu > 2) per_cu = 2;
    grid_blocks = cus * per_cu;
  }
  hipMemsetAsync((char*)d_ws + OFF_BAR, 0, XCD_BAR_WORDS * sizeof(unsigned), stream);
  void* args[] = {&P};
  hipError_t e = hipLaunchCooperativeKernel((void*)fwd_mega, dim3(grid_blocks), dim3(256), args, SMEM_BYTES, stream);
  if (e != hipSuccess) fprintf(stderr, "cooperative launch failed: %s (grid %d)\n", hipGetErrorString(e), grid_blocks);
#else
  launch_all<0>(P, stream);
#endif
}
```

```cpp
#include <hip/hip_runtime.h>
#include <hip/hip_cooperative_groups.h>
#include <stdint.h>
#include <stdio.h>

namespace cg = cooperative_groups;

#ifndef MEGA
#define MEGA 1
#endif
#define DUP_MASK 0

typedef unsigned short bf16_t;
typedef short bf16x8 __attribute__((ext_vector_type(8)));
typedef short bf16x4 __attribute__((ext_vector_type(4)));
typedef float f32x4 __attribute__((ext_vector_type(4)));
typedef float f32x2 __attribute__((ext_vector_type(2)));

#define DM 1024
#define TPB 16640
#define MROWS 33280
#define DFF 2816
#define LOG2E 1.4426950408889634f
#define LSTR 80

#define OFF_WIN   0ull
#define OFF_WOUT  6815744ull
#define OFF_WGU   8912896ull
#define OFF_WDN   20447232ull
#define OFF_MISC  26214400ull
#define OFF_MOD   (OFF_MISC)
#define OFF_ROPE  (OFF_MISC + 147456ull)
#define OFF_LAM   (OFF_MISC + 180224ull)
#define OFF_BAR   (OFF_MISC + 196608ull)
#define OFF_XCTX  (OFF_MISC + 262144ull)
#define OFF_WL    (OFF_MISC + 2359296ull)
#define OFF_A     (OFF_MISC + 4194304ull)
#define OFF_BIG   (OFF_A + 68157440ull)
#define SZ512     34078720ull
#define OFF_AQ    (OFF_BIG)
#define OFF_AK    (OFF_BIG + SZ512)
#define OFF_AVT   (OFF_BIG + 2 * SZ512)
#define OFF_BQ    (OFF_BIG + 3 * SZ512)
#define OFF_BK    (OFF_BIG + 4 * SZ512)
#define OFF_BVT   (OFF_BK + 8519680ull)
#define OFF_ACT   (OFF_BIG)
#define OFF_RAW   (OFF_BIG)
#define OFF_LORA  (OFF_BIG + 102236160ull)
#define OFF_D0    (OFF_BIG + 132055040ull)
#define OFF_CQ    (OFF_D0)
#define OFF_CK    (OFF_D0 + SZ512)
#define OFF_CVT   (OFF_D0 + 2 * SZ512)
#define OFF_XR    (OFF_D0)
#define OFF_XK    (OFF_D0 + 1 * SZ512)
#define OFF_XV    (OFF_D0 + 2 * SZ512)
#define OFF_KK    (OFF_D0 + 3 * SZ512)
#define OFF_DP    (OFF_D0 + 4 * SZ512)
#define OFF_AZ    (OFF_D0 + 6 * SZ512)
#define OFF_YZ    (OFF_BIG)
#define WS_NEEDED (OFF_D0 + 8 * SZ512)

struct Params {
  const float *x, *c, *ctx, *c_ctx, *ada_w, *ada_b, *norm_mix, *norm_ffn, *w_gate, *w_up, *w_down,
      *ab_w_in, *ab_w_out, *a_qn, *a_kn, *a_lambda, *a_subln, *b_qn, *b_kn, *b_sink,
      *cd_w_in, *cd_w_out, *c_qn, *c_kn, *c_rpb, *d_mu, *d_w0, *d_w2, *d_a0, *d_a2, *d_g2,
      *d_k_k, *d_k_a, *d_r_k, *d_ln_w, *d_ln_b;
  float* out;
  char* ws;
};

__device__ __forceinline__ bf16_t f2bf(float f) {
  uint32_t u = __float_as_uint(f);
  u += 0x7fffu + ((u >> 16) & 1u);
  return (bf16_t)(u >> 16);
}
__device__ __forceinline__ float bf2f(bf16_t h) { return __uint_as_float(((uint32_t)h) << 16); }
typedef __bf16 bf16v2_t __attribute__((ext_vector_type(2)));
__device__ __forceinline__ uint32_t pack2(float a, float b) {
  const f32x2 v = (f32x2){a, b};
  const bf16v2_t r = __builtin_convertvector(v, bf16v2_t);
  return __builtin_bit_cast(uint32_t, r);
}
__device__ __forceinline__ float fexp2(float x) { return __builtin_amdgcn_exp2f(x); }
__device__ __forceinline__ float wave_sum(float v) {
#pragma unroll
  for (int o = 32; o >= 1; o >>= 1) v += __shfl_xor(v, o);
  return v;
}
__device__ __forceinline__ float sigmoidf_(float x) { return __builtin_amdgcn_rcpf(1.0f + __expf(-x)); }

template <bool DEEP, class Epi>
__device__ __forceinline__ void gemm_phase(const bf16_t* __restrict__ A, int lda, const bf16_t* __restrict__ Wt,
                                           int K, int ntn, bool lat_only, const Epi& epi, char* smem) {
  bf16_t* sA = (bf16_t*)smem;
  bf16_t* sB = sA + 128 * LSTR;
  int tid = threadIdx.x;
  asm volatile("" : "+v"(tid));
  const int lane = tid & 63, wave = tid >> 6;
  const int wm = wave >> 1, wn = wave & 1;
  const int l15 = lane & 15, quad = lane >> 4;
  const int ntm = lat_only ? 256 : 260;
  const int total = ntm * ntn;
  const int lr = tid >> 3, lc = (tid & 7) * 8;
  const uint32_t aof0 = (uint32_t)(lr * lda + lc) * 2u, bof0 = (uint32_t)(lr * K + lc) * 2u;
  const bool swz = (gridDim.x & 7) == 0;
  const int xcd = swz ? (blockIdx.x & 7) : 0, lb = swz ? (blockIdx.x >> 3) : blockIdx.x, nlb = swz ? (gridDim.x >> 3) : gridDim.x;
  const int m_lo = swz ? (ntm * xcd) / 8 : 0, m_hi = swz ? (ntm * (xcd + 1)) / 8 : ntm;
  const int nm = m_hi - m_lo;
  const int total_x = nm * ntn;
  (void)total;
  for (int t = lb; t < total_x; t += nlb) {
    const int g = t / (8 * ntn), r = t - g * 8 * ntn;
    const int gsz = min(8, nm - g * 8);
    const int ni = r / gsz, mm = r - ni * gsz;
    const int mi = m_lo + g * 8 + mm;
    const int mt = lat_only ? ((mi >> 7) * 130 + 2 + (mi & 127)) : mi;
    const int row0 = mt * 128, col0 = ni * 128;
    const bf16_t* Ap = A + (size_t)(row0 + lr) * lda + lc;
    const bf16_t* Bp = Wt + (size_t)(col0 + lr) * K + lc;
    f32x4 acc[4][4];
#pragma unroll
    for (int i = 0; i < 4; ++i)
#pragma unroll
      for (int j = 0; j < 4; ++j) acc[i][j] = (f32x4){0.f, 0.f, 0.f, 0.f};
    uint4 ra0, ra1, ra2, ra3, rb0, rb1, rb2, rb3;
    uint4 rc0, rc1, rc2, rc3, rd0, rd1, rd2, rd3;
#define GEMM_LOAD(a0, a1, a2, a3, b0, b1, b2, b3, kk_)                       \
  {                                                                          \
    const char* ab = (const char*)(A + (size_t)row0 * lda + (kk_));          \
    const char* bb = (const char*)(Wt + (size_t)col0 * K + (kk_));           \
    a0 = *(const uint4*)(ab + aof0);                                         \
    a1 = *(const uint4*)(ab + (size_t)64 * lda + aof0);                      \
    a2 = *(const uint4*)(ab + (size_t)128 * lda + aof0);                     \
    a3 = *(const uint4*)(ab + (size_t)192 * lda + aof0);                     \
    b0 = *(const uint4*)(bb + bof0);                                         \
    b1 = *(const uint4*)(bb + (size_t)64 * K + bof0);                        \
    b2 = *(const uint4*)(bb + (size_t)128 * K + bof0);                       \
    b3 = *(const uint4*)(bb + (size_t)192 * K + bof0);                       \
  }
#define GEMM_STORE(a0, a1, a2, a3, b0, b1, b2, b3, buf_)                   \
  {                                                                        \
    bf16_t* wa = sA + (buf_) * (256 * LSTR);                               \
    bf16_t* wb = wa + 128 * LSTR;                                          \
    *(uint4*)(wa + (lr) * LSTR + lc) = a0;                                 \
    *(uint4*)(wa + (lr + 32) * LSTR + lc) = a1;                            \
    *(uint4*)(wa + (lr + 64) * LSTR + lc) = a2;                            \
    *(uint4*)(wa + (lr + 96) * LSTR + lc) = a3;                            \
    *(uint4*)(wb + (lr) * LSTR + lc) = b0;                                 \
    *(uint4*)(wb + (lr + 32) * LSTR + lc) = b1;                            \
    *(uint4*)(wb + (lr + 64) * LSTR + lc) = b2;                            \
    *(uint4*)(wb + (lr + 96) * LSTR + lc) = b3;                            \
  }
#define GEMM_MMA(buf_, ks_)                                                                                              \
  {                                                                                                                      \
    const bf16_t* ca = sA + (buf_) * (256 * LSTR);                                                                       \
    const bf16_t* cb = ca + 128 * LSTR;                                                                                  \
    bf16x8 af[4], bfr[4];                                                                                                \
    _Pragma("unroll") for (int i = 0; i < 4; ++i)                                                                        \
        af[i] = *(const bf16x8*)(ca + (wm * 64 + i * 16 + l15) * LSTR + (ks_) * 32 + quad * 8);                         \
    _Pragma("unroll") for (int j = 0; j < 4; ++j)                                                                        \
        bfr[j] = *(const bf16x8*)(cb + (wn * 64 + j * 16 + l15) * LSTR + (ks_) * 32 + quad * 8);                        \
    _Pragma("unroll") for (int i = 0; i < 4; ++i) _Pragma("unroll") for (int j = 0; j < 4; ++j)                          \
        acc[i][j] = __builtin_amdgcn_mfma_f32_16x16x32_bf16(bfr[j], af[i], acc[i][j], 0, 0, 0);                         \
  }
    const int nk = K >> 6;
    GEMM_LOAD(ra0, ra1, ra2, ra3, rb0, rb1, rb2, rb3, 0)
    (void)rc0; (void)rc1; (void)rc2; (void)rc3; (void)rd0; (void)rd1; (void)rd2; (void)rd3;
#pragma clang loop unroll(disable)
    for (int kt = 0; kt < nk; ++kt) {
      __syncthreads();
      GEMM_STORE(ra0, ra1, ra2, ra3, rb0, rb1, rb2, rb3, 0)
      __syncthreads();
      {
        bf16x8 af0[4], bf0[4], af1[4], bf1[4];
        __builtin_amdgcn_s_setprio(1);
#pragma unroll
        for (int i = 0; i < 4; ++i) af0[i] = *(const bf16x8*)(sA + (wm * 64 + i * 16 + l15) * LSTR + quad * 8);
#pragma unroll
        for (int j = 0; j < 4; ++j) bf0[j] = *(const bf16x8*)(sB + (wn * 64 + j * 16 + l15) * LSTR + quad * 8);
#pragma unroll
        for (int i = 0; i < 4; ++i) af1[i] = *(const bf16x8*)(sA + (wm * 64 + i * 16 + l15) * LSTR + 32 + quad * 8);
#pragma unroll
        for (int j = 0; j < 4; ++j) bf1[j] = *(const bf16x8*)(sB + (wn * 64 + j * 16 + l15) * LSTR + 32 + quad * 8);
        __builtin_amdgcn_sched_barrier(0);
        if (kt + 1 < nk) GEMM_LOAD(ra0, ra1, ra2, ra3, rb0, rb1, rb2, rb3, (kt + 1) * 64)
        __builtin_amdgcn_sched_barrier(0);
#pragma unroll
        for (int i = 0; i < 4; ++i)
#pragma unroll
          for (int j = 0; j < 4; ++j) acc[i][j] = __builtin_amdgcn_mfma_f32_16x16x32_bf16(bf0[j], af0[i], acc[i][j], 0, 0, 0);
#pragma unroll
        for (int i = 0; i < 4; ++i)
#pragma unroll
          for (int j = 0; j < 4; ++j) acc[i][j] = __builtin_amdgcn_mfma_f32_16x16x32_bf16(bf1[j], af1[i], acc[i][j], 0, 0, 0);
        __builtin_amdgcn_s_setprio(0);
      }
    }
    asm volatile("" ::: "memory");
    epi(acc, row0 + wm * 64, col0 + wn * 64, l15, quad);
  }
}

struct EpiIn0 {
  const float *a_qn, *a_kn, *b_qn, *b_kn, *rope;
  bf16_t *AQ, *AK, *AVT, *BQ, *BK, *BVT;
  __device__ __forceinline__ void operator()(const f32x4 (&acc)[4][4], int row0w, int col0w, int l15, int quad) const {
    const int cb = col0w >> 6;
    int kind;
    const float* gain = nullptr;
    bool isq = false;
    if (cb < 8) { kind = 0; gain = a_qn; isq = true; }
    else if (cb < 16) { kind = 1; gain = a_kn; }
    else if (cb < 24) { kind = 2; }
    else if (cb < 32) { kind = 3; gain = b_qn; isq = true; }
    else if (cb < 34) { kind = 4; gain = b_kn; }
    else { kind = 5; }
#pragma unroll
    for (int i = 0; i < 4; ++i) {
      __builtin_amdgcn_sched_barrier(0);
      const int row = row0w + i * 16 + l15;
      const int b = row / TPB, kidx = row - b * TPB;
      float v[4][4];
#pragma unroll
      for (int j = 0; j < 4; ++j)
#pragma unroll
        for (int e = 0; e < 4; ++e) v[j][e] = acc[i][j][e];
      if (gain) {
        float ss = 0.f;
#pragma unroll
        for (int j = 0; j < 4; ++j)
#pragma unroll
          for (int e = 0; e < 4; ++e) ss += v[j][e] * v[j][e];
        ss += __shfl_xor(ss, 16);
        ss += __shfl_xor(ss, 32);
        const float rstd = rsqrtf(ss * (1.0f / 64.0f) + 1e-6f);
#pragma unroll
        for (int j = 0; j < 4; ++j)
#pragma unroll
          for (int e = 0; e < 4; ++e) v[j][e] *= rstd * gain[j * 16 + quad * 4 + e];
        if (kidx >= 256) {
          const int t = kidx - 256, pr = t >> 6, pc = t & 63;
#pragma unroll
          for (int e = 0; e < 4; ++e) {
            const int f = quad * 4 + e;
            const float cr = rope[(pr * 16 + f) * 2], sr = rope[(pr * 16 + f) * 2 + 1];
            const float cc = rope[(pc * 16 + f) * 2], sc = rope[(pc * 16 + f) * 2 + 1];
            float x1 = v[0][e], x2 = v[1][e];
            v[0][e] = x1 * cr - x2 * sr;
            v[1][e] = x2 * cr + x1 * sr;
            x1 = v[2][e]; x2 = v[3][e];
            v[2][e] = x1 * cc - x2 * sc;
            v[3][e] = x2 * cc + x1 * sc;
          }
        }
        if (isq) {
#pragma unroll
          for (int j = 0; j < 4; ++j)
#pragma unroll
            for (int e = 0; e < 4; ++e) v[j][e] *= 0.125f * LOG2E;
        }
      }
      if (kind == 2) {
#pragma unroll
        for (int j = 0; j < 4; ++j)
#pragma unroll
          for (int e = 0; e < 4; ++e) {
            const int c = (cb - 16) * 64 + j * 16 + quad * 4 + e;
            AVT[((size_t)(b * 4 + (c >> 7)) * 128 + (c & 127)) * TPB + kidx] = f2bf(v[j][e]);
          }
      } else if (kind == 5) {
#pragma unroll
        for (int j = 0; j < 4; ++j)
#pragma unroll
          for (int e = 0; e < 4; ++e) {
            const int d = j * 16 + quad * 4 + e;
            BVT[((size_t)(b * 2 + (cb - 34)) * 64 + d) * TPB + kidx] = f2bf(v[j][e]);
          }
      } else {
        bf16_t* dst;
        if (kind == 0) dst = AQ + (size_t)row * 512 + cb * 64;
        else if (kind == 1) dst = AK + (size_t)row * 512 + (cb - 8) * 64;
        else if (kind == 3) dst = BQ + (size_t)row * 512 + (cb - 24) * 64;
        else dst = BK + (size_t)row * 128 + (cb - 32) * 64;
#pragma unroll
        for (int j = 0; j < 4; ++j) {
          uint2 w;
          w.x = pack2(v[j][0], v[j][1]);
          w.y = pack2(v[j][2], v[j][3]);
          *(uint2*)(dst + j * 16 + quad * 4) = w;
        }
      }
    }
  }
};

struct EpiIn1 {
  const float *c_qn, *c_kn;
  bf16_t *CQ, *CK, *CVT, *RAW;
  float* LORA;
  __device__ __forceinline__ void operator()(const f32x4 (&acc)[4][4], int row0w, int col0w, int l15, int quad) const {
    const int cb = col0w >> 6;
#pragma unroll
    for (int i = 0; i < 4; ++i) {
      const int row = row0w + i * 16 + l15;
      const int b = row / TPB, kidx = row - b * TPB;
      float v[4][4];
#pragma unroll
      for (int j = 0; j < 4; ++j)
#pragma unroll
        for (int e = 0; e < 4; ++e) v[j][e] = acc[i][j][e];
      if (cb < 16) {
        const float* gain = cb < 8 ? c_qn : c_kn;
        float ss = 0.f;
#pragma unroll
        for (int j = 0; j < 4; ++j)
#pragma unroll
          for (int e = 0; e < 4; ++e) ss += v[j][e] * v[j][e];
        ss += __shfl_xor(ss, 16);
        ss += __shfl_xor(ss, 32);
        const float rstd = rsqrtf(ss * (1.0f / 64.0f) + 1e-6f) * (cb < 8 ? 0.125f * LOG2E : 1.0f);
        bf16_t* dst = (cb < 8 ? CQ + (size_t)row * 512 + cb * 64 : CK + (size_t)row * 512 + (cb - 8) * 64);
#pragma unroll
        for (int j = 0; j < 4; ++j) {
          const float* gp = gain + j * 16 + quad * 4;
          uint2 w;
          w.x = pack2(v[j][0] * rstd * gp[0], v[j][1] * rstd * gp[1]);
          w.y = pack2(v[j][2] * rstd * gp[2], v[j][3] * rstd * gp[3]);
          *(uint2*)(dst + j * 16 + quad * 4) = w;
        }
      } else if (cb < 24) {
#pragma unroll
        for (int j = 0; j < 4; ++j)
#pragma unroll
          for (int e = 0; e < 4; ++e) {
            const int d = j * 16 + quad * 4 + e;
            CVT[((size_t)(b * 8 + (cb - 16)) * 64 + d) * TPB + kidx] = f2bf(v[j][e]);
          }
      } else if (cb < 48) {
        bf16_t* dst = RAW + (size_t)row * 1536 + (cb - 24) * 64;
#pragma unroll
        for (int j = 0; j < 4; ++j) {
          uint2 w;
          w.x = pack2(v[j][0], v[j][1]);
          w.y = pack2(v[j][2], v[j][3]);
          *(uint2*)(dst + j * 16 + quad * 4) = w;
        }
      } else {
#pragma unroll
        for (int j = 0; j < 4; ++j) {
          const int c = (cb - 48) * 64 + j * 16 + quad * 4;
          if (c < 224) *(float4*)(LORA + (size_t)row * 224 + c) = make_float4(v[j][0], v[j][1], v[j][2], v[j][3]);
        }
      }
    }
  }
};

struct EpiRes {
  const float *lat_src, *ctx_src;
  float *lat_dst, *ctx_dst;
  const float* gate;
  __device__ __forceinline__ void operator()(const f32x4 (&acc)[4][4], int row0w, int col0w, int l15, int quad) const {
#pragma unroll
    for (int i = 0; i < 4; ++i) {
      const int row = row0w + i * 16 + l15;
      const int b = row / TPB, kidx = row - b * TPB;
      const bool isc = kidx < 256;
      const size_t off = isc ? (size_t)(b * 256 + kidx) * DM : (size_t)(b * 16384 + kidx - 256) * DM;
      const float* src = (isc ? ctx_src : lat_src) + off;
      float* dst = (isc ? ctx_dst : lat_dst) + off;
      const float* g = gate + (isc ? 2 : b) * 6144;
#pragma unroll
      for (int j = 0; j < 4; ++j) {
        const int n = col0w + j * 16 + quad * 4;
        const float4 xo = *(const float4*)(src + n);
        const float4 g4 = *(const float4*)(g + n);
        float4 o;
        o.x = xo.x + g4.x * acc[i][j][0];
        o.y = xo.y + g4.y * acc[i][j][1];
        o.z = xo.z + g4.z * acc[i][j][2];
        o.w = xo.w + g4.w * acc[i][j][3];
        *(float4*)(dst + n) = o;
      }
    }
  }
};

struct EpiGU {
  bf16_t* ACT;
  __device__ __forceinline__ void operator()(const f32x4 (&acc)[4][4], int row0w, int col0w, int l15, int quad) const {
    const int chunk = col0w >> 6;
#pragma unroll
    for (int i = 0; i < 4; ++i) {
      const int row = row0w + i * 16 + l15;
#pragma unroll
      for (int j = 0; j < 2; ++j) {
        float r[4];
#pragma unroll
        for (int e = 0; e < 4; ++e) {
          const float g = acc[i][j][e], u = acc[i][j + 2][e];
          r[e] = g * sigmoidf_(g) * u;
        }
        uint2 w;
        w.x = pack2(r[0], r[1]);
        w.y = pack2(r[2], r[3]);
        *(uint2*)(ACT + (size_t)row * DFF + chunk * 32 + j * 16 + quad * 4) = w;
      }
    }
  }
};

template <int NMAP, int NDT, int MODE, bool FIXED>
__device__ __forceinline__ void attn_unit(const bf16_t* __restrict__ Qp, int ldq, const bf16_t* __restrict__ Kp, int ldk,
                                          const bf16_t* __restrict__ Vtp, int seg_lo, int nseg, int qk0,
                                          const float* s_rpb, int na_i, int na_r0, float negM,
                                          f32x4 (&o)[NMAP][NDT], float (&m)[NMAP], float (&l)[NMAP], char* smem) {
  bf16_t* sK = (bf16_t*)smem;
  bf16_t* sVt = sK + NMAP * 64 * LSTR;
  int tid = threadIdx.x;
  asm volatile("" : "+v"(tid));
  const int lane = tid & 63, wave = tid >> 6;
  const int l15 = lane & 15, quad = lane >> 4;
  bf16x8 qf[NMAP][2];
  {
    const bf16_t* qrow = Qp + (size_t)(wave * 16 + l15) * ldq;
#pragma unroll
    for (int c = 0; c < NMAP; ++c)
#pragma unroll
      for (int ks = 0; ks < 2; ++ks) qf[c][ks] = *(const bf16x8*)(qrow + c * 64 + ks * 32 + quad * 8);
  }
#pragma unroll
  for (int c = 0; c < NMAP; ++c) {
    m[c] = -1e30f;
    l[c] = 0.f;
#pragma unroll
    for (int dt = 0; dt < NDT; ++dt) o[c][dt] = (f32x4){0.f, 0.f, 0.f, 0.f};
  }
  const int ntiles = 4 + nseg;
  constexpr int NVL = NDT / 2;
  uint4 rk00, rk01, rk10, rk11, rv0, rv1, rv2, rv3;
  rk10 = rk11 = rv2 = rv3 = make_uint4(0, 0, 0, 0);
  const int lr = tid >> 3, lch = (tid & 7) * 8;
  const uint32_t koff0 = (uint32_t)(lr * ldk + lch) * 2u, koff1 = (uint32_t)((lr + 32) * ldk + lch) * 2u;
  const uint32_t voff0 = (uint32_t)(lr * TPB + lch) * 2u, voff1 = (uint32_t)((lr + 32) * TPB + lch) * 2u,
                 voff2 = (uint32_t)((lr + 64) * TPB + lch) * 2u, voff3 = (uint32_t)((lr + 96) * TPB + lch) * 2u;
#define ATTN_LOAD_K(k0_)                                              \
  {                                                                   \
    const char* kb = (const char*)(Kp + (size_t)(k0_) * ldk);         \
    rk00 = *(const uint4*)(kb + koff0);                               \
    rk01 = *(const uint4*)(kb + koff1);                               \
    if (NMAP > 1) {                                                   \
      rk10 = *(const uint4*)(kb + 128 + koff0);                       \
      rk11 = *(const uint4*)(kb + 128 + koff1);                       \
    }                                                                 \
  }
#define ATTN_LOAD_V(k0_)                                              \
  {                                                                   \
    const char* vb = (const char*)(Vtp + (k0_));                      \
    rv0 = *(const uint4*)(vb + voff0);                                \
    rv1 = *(const uint4*)(vb + voff1);                                \
    if (NVL > 2) {                                                    \
      rv2 = *(const uint4*)(vb + voff2);                              \
      rv3 = *(const uint4*)(vb + voff3);                              \
    }                                                                 \
  }
  ATTN_LOAD_K(0)
  ATTN_LOAD_V(0)
  for (int n = 0; n < ntiles; ++n) {
    const int kidx0 = (MODE == 0) ? n * 64 : (n < 4 ? n * 64 : seg_lo + (n - 4) * 64);
    __syncthreads();
    *(uint4*)(sK + (lr) * LSTR + lch) = rk00;
    *(uint4*)(sK + (lr + 32) * LSTR + lch) = rk01;
    if (NMAP > 1) {
      *(uint4*)(sK + (64 + lr) * LSTR + lch) = rk10;
      *(uint4*)(sK + (64 + lr + 32) * LSTR + lch) = rk11;
    }
    *(uint4*)(sVt + (lr) * LSTR + lch) = rv0;
    *(uint4*)(sVt + (lr + 32) * LSTR + lch) = rv1;
    if (NVL > 2) {
      *(uint4*)(sVt + (lr + 64) * LSTR + lch) = rv2;
      *(uint4*)(sVt + (lr + 96) * LSTR + lch) = rv3;
    }
    __syncthreads();
    const int knext = (MODE == 0) ? (n + 1) * 64 : ((n + 1) < 4 ? (n + 1) * 64 : seg_lo + (n + 1 - 4) * 64);
    if (n + 1 < ntiles) {
      ATTN_LOAD_K(knext)
    }
    bf16x8 pf[NMAP][2];
#pragma unroll
    for (int c = 0; c < NMAP; ++c) {
      f32x4 s[4];
#pragma unroll
      for (int kt = 0; kt < 4; ++kt) {
        const float ini = FIXED ? negM : 0.f;
        s[kt] = (f32x4){ini, ini, ini, ini};
        const int krow = 32 * (kt >> 1) + (l15 >> 2) * 8 + (kt & 1) * 4 + (l15 & 3);
#pragma unroll
        for (int ks = 0; ks < 2; ++ks) {
          const bf16x8 kf = *(const bf16x8*)(sK + (c * 64 + krow) * LSTR + ks * 32 + quad * 8);
          s[kt] = __builtin_amdgcn_mfma_f32_16x16x32_bf16(kf, qf[c][ks], s[kt], 0, 0, 0);
        }
      }
      if (MODE == 1 && n >= 4) {
        const int kp0 = kidx0 - 256, qp = qk0 - 256 + wave * 16 + l15;
#pragma unroll
        for (int kt = 0; kt < 4; ++kt)
#pragma unroll
          for (int e = 0; e < 4; ++e) {
            const int d = qp - (kp0 + 32 * (kt >> 1) + quad * 8 + (kt & 1) * 4 + e);
            if (d > 128 || d < -128) s[kt][e] = -1e30f;
          }
      }
      if (MODE == 2 && n >= 4) {
        const int ri = na_r0 + (n - 4) - na_i + 7;
        const int qc = wave * 16 + l15;
        const int cs = min(max(qc - 8, 0), 48);
#pragma unroll
        for (int kt = 0; kt < 4; ++kt)
#pragma unroll
          for (int e = 0; e < 4; ++e) {
            const int kc = 32 * (kt >> 1) + quad * 8 + (kt & 1) * 4 + e;
            if (kc >= cs && kc < cs + 16) s[kt][e] += s_rpb[ri * 31 + kc - qc + 15];
            else s[kt][e] = -1e30f;
          }
      }
      if (FIXED) {
        float ls = 0.f;
#pragma unroll
        for (int kt = 0; kt < 4; ++kt)
#pragma unroll
          for (int e = 0; e < 4; ++e) {
            s[kt][e] = fexp2(s[kt][e]);
            ls += s[kt][e];
          }
        l[c] += ls;
      } else {
        float mx = s[0][0];
#pragma unroll
        for (int kt = 0; kt < 4; ++kt)
#pragma unroll
          for (int e = 0; e < 4; ++e) mx = fmaxf(mx, s[kt][e]);
        mx = fmaxf(mx, __shfl_xor(mx, 16));
        mx = fmaxf(mx, __shfl_xor(mx, 32));
        const float mnew = fmaxf(m[c], mx);
        const float alpha = fexp2(m[c] - mnew);
        m[c] = mnew;
        float ls = 0.f;
#pragma unroll
        for (int kt = 0; kt < 4; ++kt)
#pragma unroll
          for (int e = 0; e < 4; ++e) {
            s[kt][e] = fexp2(s[kt][e] - mnew);
            ls += s[kt][e];
          }
        l[c] = l[c] * alpha + ls;
        if (__ballot(alpha != 1.0f) != 0ull) {
#pragma unroll
          for (int dt = 0; dt < NDT; ++dt) o[c][dt] *= alpha;
        }
      }
      __builtin_amdgcn_sched_barrier(0);
#pragma unroll
      for (int ks2 = 0; ks2 < 2; ++ks2) {
        union { uint32_t u[4]; bf16x8 v; } pk;
        pk.u[0] = pack2(s[2 * ks2][0], s[2 * ks2][1]);
        pk.u[1] = pack2(s[2 * ks2][2], s[2 * ks2][3]);
        pk.u[2] = pack2(s[2 * ks2 + 1][0], s[2 * ks2 + 1][1]);
        pk.u[3] = pack2(s[2 * ks2 + 1][2], s[2 * ks2 + 1][3]);
        pf[c][ks2] = pk.v;
      }
    }
    if (n + 1 < ntiles) {
      ATTN_LOAD_V(knext)
    }
#pragma unroll
    for (int ks2 = 0; ks2 < 2; ++ks2) {
      __builtin_amdgcn_sched_barrier(0);
#pragma unroll
      for (int dt = 0; dt < NDT; ++dt) {
        const bf16x8 vf = *(const bf16x8*)(sVt + (dt * 16 + l15) * LSTR + 32 * ks2 + quad * 8);
#pragma unroll
        for (int c = 0; c < NMAP; ++c) o[c][dt] = __builtin_amdgcn_mfma_f32_16x16x32_bf16(vf, pf[c][ks2], o[c][dt], 0, 0, 0);
      }
    }
  }
#pragma unroll
  for (int c = 0; c < NMAP; ++c) {
    l[c] += __shfl_xor(l[c], 16);
    l[c] += __shfl_xor(l[c], 32);
  }
}

__device__ __forceinline__ void attn_diff32(const bf16_t* __restrict__ Qp, const bf16_t* __restrict__ Kp,
                                            const bf16_t* __restrict__ Vtp, int ntiles, float negM,
                                            f32x4 (&o)[2][8], float (&l)[2], char* smem) {
  bf16_t* sK = (bf16_t*)smem;
  bf16_t* sVt = sK + 2 * 64 * LSTR;
  int tid = threadIdx.x;
  asm volatile("" : "+v"(tid));
  const int lane = tid & 63, wave = tid >> 6;
  const int l15 = lane & 15, quad = lane >> 4;
  const int cmap = wave >> 1, qg = wave & 1;
  bf16x8 qf[2][2];
#pragma unroll
  for (int qt = 0; qt < 2; ++qt) {
    const bf16_t* qrow = Qp + (size_t)(qg * 32 + qt * 16 + l15) * 512 + cmap * 64;
#pragma unroll
    for (int ks = 0; ks < 2; ++ks) qf[qt][ks] = *(const bf16x8*)(qrow + ks * 32 + quad * 8);
  }
#pragma unroll
  for (int qt = 0; qt < 2; ++qt) {
    l[qt] = 0.f;
#pragma unroll
    for (int dt = 0; dt < 8; ++dt) o[qt][dt] = (f32x4){0.f, 0.f, 0.f, 0.f};
  }
  uint4 rk00, rk01, rk10, rk11, rv0, rv1, rv2, rv3;
  const int lr = tid >> 3, lch = (tid & 7) * 8;
  const uint32_t koff0 = (uint32_t)(lr * 512 + lch) * 2u, koff1 = (uint32_t)((lr + 32) * 512 + lch) * 2u;
  const uint32_t voff0 = (uint32_t)(lr * TPB + lch) * 2u, voff1 = (uint32_t)((lr + 32) * TPB + lch) * 2u,
                 voff2 = (uint32_t)((lr + 64) * TPB + lch) * 2u, voff3 = (uint32_t)((lr + 96) * TPB + lch) * 2u;
#define AD_LOAD_K(k0_)                                                \
  {                                                                   \
    const char* kb = (const char*)(Kp + (size_t)(k0_) * 512);         \
    rk00 = *(const uint4*)(kb + koff0);                               \
    rk01 = *(const uint4*)(kb + koff1);                               \
    rk10 = *(const uint4*)(kb + 128 + koff0);                         \
    rk11 = *(const uint4*)(kb + 128 + koff1);                         \
  }
#define AD_LOAD_V(k0_)                                                \
  {                                                                   \
    const char* vb = (const char*)(Vtp + (k0_));                      \
    rv0 = *(const uint4*)(vb + voff0);                                \
    rv1 = *(const uint4*)(vb + voff1);                                \
    rv2 = *(const uint4*)(vb + voff2);                                \
    rv3 = *(const uint4*)(vb + voff3);                                \
  }
  AD_LOAD_K(0)
  AD_LOAD_V(0)
  const bf16_t* sKc = sK + cmap * 64 * LSTR;
  for (int n = 0; n < ntiles; ++n) {
    __syncthreads();
    *(uint4*)(sK + (lr) * LSTR + lch) = rk00;
    *(uint4*)(sK + (lr + 32) * LSTR + lch) = rk01;
    *(uint4*)(sK + (64 + lr) * LSTR + lch) = rk10;
    *(uint4*)(sK + (64 + lr + 32) * LSTR + lch) = rk11;
    *(uint4*)(sVt + (lr) * LSTR + lch) = rv0;
    *(uint4*)(sVt + (lr + 32) * LSTR + lch) = rv1;
    *(uint4*)(sVt + (lr + 64) * LSTR + lch) = rv2;
    *(uint4*)(sVt + (lr + 96) * LSTR + lch) = rv3;
    __syncthreads();
    const int knext = (n + 1) * 64;
    if (n + 1 < ntiles) { AD_LOAD_K(knext) }
    f32x4 s[2][4];
    __builtin_amdgcn_s_setprio(1);
#pragma unroll
    for (int kt = 0; kt < 4; ++kt) {
      s[0][kt] = (f32x4){negM, negM, negM, negM};
      s[1][kt] = (f32x4){negM, negM, negM, negM};
      const int krow = 32 * (kt >> 1) + (l15 >> 2) * 8 + (kt & 1) * 4 + (l15 & 3);
#pragma unroll
      for (int ks = 0; ks < 2; ++ks) {
        const bf16x8 kf = *(const bf16x8*)(sKc + krow * LSTR + ks * 32 + quad * 8);
        s[0][kt] = __builtin_amdgcn_mfma_f32_16x16x32_bf16(kf, qf[0][ks], s[0][kt], 0, 0, 0);
        s[1][kt] = __builtin_amdgcn_mfma_f32_16x16x32_bf16(kf, qf[1][ks], s[1][kt], 0, 0, 0);
      }
    }
    __builtin_amdgcn_s_setprio(0);
    bf16x8 pf[2][2];
#pragma unroll
    for (int qt = 0; qt < 2; ++qt) {
      float ls = 0.f;
#pragma unroll
      for (int kt = 0; kt < 4; ++kt)
#pragma unroll
        for (int e = 0; e < 4; ++e) {
          s[qt][kt][e] = fexp2(s[qt][kt][e]);
          ls += s[qt][kt][e];
        }
      l[qt] += ls;
#pragma unroll
      for (int ks2 = 0; ks2 < 2; ++ks2) {
        union { uint32_t u[4]; bf16x8 v; } pk;
        pk.u[0] = pack2(s[qt][2 * ks2][0], s[qt][2 * ks2][1]);
        pk.u[1] = pack2(s[qt][2 * ks2][2], s[qt][2 * ks2][3]);
        pk.u[2] = pack2(s[qt][2 * ks2 + 1][0], s[qt][2 * ks2 + 1][1]);
        pk.u[3] = pack2(s[qt][2 * ks2 + 1][2], s[qt][2 * ks2 + 1][3]);
        pf[qt][ks2] = pk.v;
      }
    }
    if (n + 1 < ntiles) { AD_LOAD_V(knext) }
    __builtin_amdgcn_s_setprio(1);
#pragma unroll
    for (int ks2 = 0; ks2 < 2; ++ks2)
#pragma unroll
      for (int dt = 0; dt < 8; ++dt) {
        const bf16x8 vf = *(const bf16x8*)(sVt + (dt * 16 + l15) * LSTR + 32 * ks2 + quad * 8);
        o[0][dt] = __builtin_amdgcn_mfma_f32_16x16x32_bf16(vf, pf[0][ks2], o[0][dt], 0, 0, 0);
        o[1][dt] = __builtin_amdgcn_mfma_f32_16x16x32_bf16(vf, pf[1][ks2], o[1][dt], 0, 0, 0);
      }
    __builtin_amdgcn_s_setprio(0);
  }
#pragma unroll
  for (int qt = 0; qt < 2; ++qt) {
    l[qt] += __shfl_xor(l[qt], 16);
    l[qt] += __shfl_xor(l[qt], 32);
  }
}

__device__ __forceinline__ void phase_attn0(const Params& P, char* smem) {
  char* ws = P.ws;
  const bf16_t* AQ = (const bf16_t*)(ws + OFF_AQ);
  const bf16_t* AK = (const bf16_t*)(ws + OFF_AK);
  const bf16_t* AVT = (const bf16_t*)(ws + OFF_AVT);
  const bf16_t* BQ = (const bf16_t*)(ws + OFF_BQ);
  const bf16_t* BK = (const bf16_t*)(ws + OFF_BK);
  const bf16_t* BVT = (const bf16_t*)(ws + OFF_BVT);
  bf16_t* Acat = (bf16_t*)(ws + OFF_A);
  const float lam = ((const float*)(ws + OFF_LAM))[0];
  const float negM = -((const float*)(ws + OFF_LAM))[1];
  const bool fixed_ok = ((const float*)(ws + OFF_LAM))[1] < 60.0f;
  const float lambda_init = 0.2f;
  const int lane = threadIdx.x & 63, wave = threadIdx.x >> 6, l15 = lane & 15, quad = lane >> 4;
  for (int u = blockIdx.x; u < 2080; u += gridDim.x) {
    int b, head, qb;
    if (u < 2048) {
      const int bh = u & 7;
      b = bh >> 2; head = bh & 3; qb = 4 + (u >> 3);
    }
    else { const int cu = u - 2048; b = cu >> 4; head = (cu >> 2) & 3; qb = cu & 3; }
    const int qk0 = qb * 64;
    const int nseg = qb >= 4 ? 256 : 0;
    f32x4 o[2][8];
    float m[2], l[2];
    if (fixed_ok) {
      f32x4 o2[2][8];
      float l2[2];
      attn_diff32(AQ + (size_t)(b * TPB + qk0) * 512 + head * 128, AK + (size_t)(b * TPB) * 512 + head * 128,
                  AVT + (size_t)(b * 4 + head) * 128 * TPB, 4 + nseg, negM, o2, l2, smem);
      float* xch = (float*)smem;
      const int cmap = wave >> 1, qg = wave & 1;
      __syncthreads();
      if (cmap == 1) {
#pragma unroll
        for (int qt = 0; qt < 2; ++qt) {
          const float i1 = lam / l2[qt];
#pragma unroll
          for (int dt = 0; dt < 8; ++dt)
            *(f32x4*)(xch + (size_t)((qg * 32 + qt * 16 + l15) * 128 + dt * 16 + quad * 4)) = o2[qt][dt] * i1;
        }
      }
      __syncthreads();
      if (cmap == 0) {
#pragma unroll
        for (int qt = 0; qt < 2; ++qt) {
          const float i0 = 1.0f / l2[qt];
          float ss = 0.f;
#pragma unroll
          for (int dt = 0; dt < 8; ++dt) {
            const f32x4 other = *(const f32x4*)(xch + (size_t)((qg * 32 + qt * 16 + l15) * 128 + dt * 16 + quad * 4));
            o2[qt][dt] = o2[qt][dt] * i0 - other;
#pragma unroll
            for (int e = 0; e < 4; ++e) ss += o2[qt][dt][e] * o2[qt][dt][e];
          }
          ss += __shfl_xor(ss, 16);
          ss += __shfl_xor(ss, 32);
          const float rstd = rsqrtf(ss * (1.0f / 128.0f) + 1e-6f) * (1.0f - lambda_init);
          const int row = b * TPB + qk0 + qg * 32 + qt * 16 + l15;
          bf16_t* dst = Acat + (size_t)row * DM + head * 128;
#pragma unroll
          for (int dt = 0; dt < 8; ++dt) {
            const float* sg = P.a_subln + dt * 16 + quad * 4;
            uint2 w;
            w.x = pack2(o2[qt][dt][0] * rstd * sg[0], o2[qt][dt][1] * rstd * sg[1]);
            w.y = pack2(o2[qt][dt][2] * rstd * sg[2], o2[qt][dt][3] * rstd * sg[3]);
            *(uint2*)(dst + dt * 16 + quad * 4) = w;
          }
        }
      }
      continue;
    }
    {
      attn_unit<2, 8, 0, false>(AQ + (size_t)(b * TPB + qk0) * 512 + head * 128, 512, AK + (size_t)(b * TPB) * 512 + head * 128, 512,
                                AVT + (size_t)(b * 4 + head) * 128 * TPB, 256, nseg, qk0, nullptr, 0, 0, 0.f, o, m, l, smem);
    }

    const float i0 = 1.0f / l[0], i1 = lam / l[1];
    float ss = 0.f;
#pragma unroll
    for (int dt = 0; dt < 8; ++dt)
#pragma unroll
      for (int e = 0; e < 4; ++e) {
        const float v = o[0][dt][e] * i0 - o[1][dt][e] * i1;
        o[0][dt][e] = v;
        ss += v * v;
      }
    ss += __shfl_xor(ss, 16);
    ss += __shfl_xor(ss, 32);
    const float rstd = rsqrtf(ss * (1.0f / 128.0f) + 1e-6f) * (1.0f - lambda_init);
    const int row = b * TPB + qk0 + wave * 16 + l15;
    bf16_t* dst = Acat + (size_t)row * DM + head * 128;
#pragma unroll
    for (int dt = 0; dt < 8; ++dt) {
      const float* sg = P.a_subln + dt * 16 + quad * 4;
      uint2 w;
      w.x = pack2(o[0][dt][0] * rstd * sg[0], o[0][dt][1] * rstd * sg[1]);
      w.y = pack2(o[0][dt][2] * rstd * sg[2], o[0][dt][3] * rstd * sg[3]);
      *(uint2*)(dst + dt * 16 + quad * 4) = w;
    }
  }
  for (int u = blockIdx.x; u < 4160; u += gridDim.x) {
    const int b = u / 2080, r = u - b * 2080, qh = r / 260, qb = r - qh * 260;
    const int g = qh >> 2;
    const int qk0 = qb * 64;
    int seg_lo = 256, nseg = 0;
    if (qb >= 4) {
      int lo = qk0 - 128, hi = qk0 + 128;
      if (lo < 256) lo = 256;
      if (hi > TPB - 64) hi = TPB - 64;
      seg_lo = lo;
      nseg = (hi - lo) / 64 + 1;
    }
    f32x4 o[1][4];
    float m[1], l[1];
    attn_unit<1, 4, 1, false>(BQ + (size_t)(b * TPB + qk0) * 512 + qh * 64, 512, BK + (size_t)(b * TPB) * 128 + g * 64, 128,
                              BVT + (size_t)(b * 2 + g) * 64 * TPB, seg_lo, nseg, qk0, nullptr, 0, 0, 0.f, o, m, l, smem);
    const float lt = l[0] + fexp2(P.b_sink[qh] * LOG2E - m[0]);
    const float inv = 1.0f / lt;
    const int row = b * TPB + qk0 + wave * 16 + l15;
    bf16_t* dst = Acat + (size_t)row * DM + 512 + qh * 64;
#pragma unroll
    for (int dt = 0; dt < 4; ++dt) {
      uint2 w;
      w.x = pack2(o[0][dt][0] * inv, o[0][dt][1] * inv);
      w.y = pack2(o[0][dt][2] * inv, o[0][dt][3] * inv);
      *(uint2*)(dst + dt * 16 + quad * 4) = w;
    }
  }
}

__device__ __forceinline__ void phase_na(const Params& P, char* smem) {
  char* ws = P.ws;
  const bf16_t* CQ = (const bf16_t*)(ws + OFF_CQ);
  const bf16_t* CK = (const bf16_t*)(ws + OFF_CK);
  const bf16_t* CVT = (const bf16_t*)(ws + OFF_CVT);
  bf16_t* Acat = (bf16_t*)(ws + OFF_A);
  float* s_rpb = (float*)(smem + 40960);
  const int lane = threadIdx.x & 63, wave = threadIdx.x >> 6, l15 = lane & 15, quad = lane >> 4;
  for (int u = blockIdx.x; u < 4096; u += gridDim.x) {
    const int b = u >> 11, h = (u >> 8) & 7, gi = u & 255;
    const int r0 = min(max(gi - 4, 0), 248);
    __syncthreads();
    for (int e = threadIdx.x; e < 465; e += 256) s_rpb[e] = P.c_rpb[h * 465 + e] * LOG2E;
    __syncthreads();
    const int qk0 = 256 + gi * 64;
    f32x4 o[1][4];
    float m[1], l[1];
    attn_unit<1, 4, 2, false>(CQ + (size_t)(b * TPB + qk0) * 512 + h * 64, 512, CK + (size_t)(b * TPB) * 512 + h * 64, 512,
                              CVT + (size_t)(b * 8 + h) * 64 * TPB, 256 + r0 * 64, 8, qk0, s_rpb, gi, r0, 0.f, o, m, l, smem);
    const float inv = 1.0f / l[0];
    const int row = b * TPB + qk0 + wave * 16 + l15;
    bf16_t* dst = Acat + (size_t)row * DM + h * 64;
#pragma unroll
    for (int dt = 0; dt < 4; ++dt) {
      uint2 w;
      w.x = pack2(o[0][dt][0] * inv, o[0][dt][1] * inv);
      w.y = pack2(o[0][dt][2] * inv, o[0][dt][3] * inv);
      *(uint2*)(dst + dt * 16 + quad * 4) = w;
    }
  }
}

__device__ __forceinline__ void phase_norm(const float* lat_src, const float* ctx_src, const float* gain, const float* modl,
                                           int sh_off, int sc_off, bf16_t* A, bool lat_only) {
  const int lane = threadIdx.x & 63, wave = threadIdx.x >> 6;
  const int total = lat_only ? 32768 : MROWS;
  for (int idx0 = (blockIdx.x * 4 + wave) * 2; idx0 < total; idx0 += gridDim.x * 8) {
    float4 xv[2][4];
    const float* md[2];
    int rowi[2];
#pragma unroll
    for (int u = 0; u < 2; ++u) {
      const int idx = idx0 + u;
      const int row = lat_only ? ((idx >> 14) * TPB + 256 + (idx & 16383)) : idx;
      const int b = row / TPB, kidx = row - b * TPB;
      const bool isc = kidx < 256;
      const float* src = isc ? ctx_src + (size_t)(b * 256 + kidx) * DM : lat_src + (size_t)(b * 16384 + kidx - 256) * DM;
      md[u] = modl + (isc ? 2 : b) * 6144;
      rowi[u] = row;
#pragma unroll
      for (int i = 0; i < 4; ++i) xv[u][i] = *(const float4*)(src + i * 256 + lane * 4);
    }
#pragma unroll
    for (int u = 0; u < 2; ++u) {
      float ss = 0.f;
#pragma unroll
      for (int i = 0; i < 4; ++i) ss += xv[u][i].x * xv[u][i].x + xv[u][i].y * xv[u][i].y + xv[u][i].z * xv[u][i].z + xv[u][i].w * xv[u][i].w;
      ss = wave_sum(ss);
      const float rstd = rsqrtf(ss * (1.0f / 1024.0f) + 1e-6f);
#pragma unroll
      for (int i = 0; i < 4; ++i) {
        const int c = i * 256 + lane * 4;
        const float4 g = *(const float4*)(gain + c);
        const float4 sh = *(const float4*)(md[u] + sh_off + c);
        const float4 sc = *(const float4*)(md[u] + sc_off + c);
        uint2 w;
        w.x = pack2(xv[u][i].x * rstd * g.x * (1.f + sc.x) + sh.x, xv[u][i].y * rstd * g.y * (1.f + sc.y) + sh.y);
        w.y = pack2(xv[u][i].z * rstd * g.z * (1.f + sc.z) + sh.z, xv[u][i].w * rstd * g.w * (1.f + sc.w) + sh.w);
        *(uint2*)(A + (size_t)rowi[u] * DM + c) = w;
      }
    }
  }
}

__device__ __forceinline__ void conv_tile(const float* __restrict__ W, int K, int N, int Npad, bf16_t* __restrict__ dst, int mode,
                          int kt, int nt, char* smem) {
  float* T = (float*)smem;
  const int tid = threadIdx.x;
  const int k0 = kt * 64, n0 = nt * 64;
  __syncthreads();
  {
    const int r = tid >> 4, c4 = (tid & 15) * 4;
#pragma unroll
    for (int i = 0; i < 4; ++i) {
      const int k = r + 16 * i, n = n0 + c4;
      float4 v = make_float4(0.f, 0.f, 0.f, 0.f);
      if (n < N) v = *(const float4*)(W + (size_t)(k0 + k) * N + n);
      T[k * 65 + c4 + 0] = v.x;
      T[k * 65 + c4 + 1] = v.y;
      T[k * 65 + c4 + 2] = v.z;
      T[k * 65 + c4 + 3] = v.w;
    }
  }
  __syncthreads();
  {
    const int n = tid >> 2, ks = (tid & 3) * 16;
    const int gn = n0 + n;
    if (gn < Npad) {
      const int drow = mode == 0 ? gn : ((gn >> 5) * 64 + (gn & 31) + (mode == 2 ? 32 : 0));
      uint32_t w[8];
#pragma unroll
      for (int q = 0; q < 8; ++q) w[q] = pack2(T[(ks + 2 * q) * 65 + n], T[(ks + 2 * q + 1) * 65 + n]);
      uint4* d = (uint4*)(dst + (size_t)drow * K + k0 + ks);
      d[0] = make_uint4(w[0], w[1], w[2], w[3]);
      d[1] = make_uint4(w[4], w[5], w[6], w[7]);
    }
  }
}

__device__ __forceinline__ void phase_conv(const Params& P, int layer, char* smem, int part, int rank, int nrank) {
  char* ws = P.ws;
  const float* w_in = layer == 0 ? P.ab_w_in : P.cd_w_in;
  const int n_in = layer == 0 ? 2304 : 3296;
  const int np_in = layer == 0 ? 2304 : 3328;
  const int nt_in = np_in / 64;
  const float* w_out = layer == 0 ? P.ab_w_out : P.cd_w_out;
  const int t_in = 16 * nt_in;
  const int t_lo = part == 2 ? t_in : 0;
  const int total = part == 1 ? t_in : t_in + 256 + 3 * 704;
  for (int t = t_lo + rank; t < total; t += nrank) {
    if (t < t_in) {
      conv_tile(w_in, 1024, n_in, np_in, (bf16_t*)(ws + OFF_WIN), 0, t / nt_in, t % nt_in, smem);
    } else if (t < t_in + 256) {
      const int q = t - t_in;
      conv_tile(w_out, 1024, 1024, 1024, (bf16_t*)(ws + OFF_WOUT), 0, q >> 4, q & 15, smem);
    } else if (t < t_in + 256 + 704) {
      const int q = t - t_in - 256;
      conv_tile(P.w_gate + (size_t)layer * 1024 * DFF, 1024, DFF, DFF, (bf16_t*)(ws + OFF_WGU), 1, q / 44, q % 44, smem);
    } else if (t < t_in + 256 + 1408) {
      const int q = t - t_in - 256 - 704;
      conv_tile(P.w_up + (size_t)layer * 1024 * DFF, 1024, DFF, DFF, (bf16_t*)(ws + OFF_WGU), 2, q / 44, q % 44, smem);
    } else {
      const int q = t - t_in - 256 - 1408;
      conv_tile(P.w_down + (size_t)layer * DFF * 1024, DFF, 1024, 1024, (bf16_t*)(ws + OFF_WDN), 0, q >> 4, q & 15, smem);
    }
  }
}

__device__ __forceinline__ void phase_adaln(const Params& P, char* smem) {
  float* sc = (float*)smem;
  float* red = sc + 3 * 1024;
  float* mod = (float*)(P.ws + OFF_MOD);
  const int tid = threadIdx.x;
  for (int it = (int)gridDim.x - 1 - (int)blockIdx.x; it < 384; it += gridDim.x) {
    const int layer = it / 192, n0 = (it % 192) * 32;
    __syncthreads();
    for (int e = tid; e < 3072; e += 256) {
      const int i = e >> 10, k = e & 1023;
      const float v = i < 2 ? P.c[i * 1024 + k] : P.c_ctx[k];
      sc[e] = v / (1.0f + __expf(-v));
    }
    __syncthreads();
    const int kg = tid >> 5, col = tid & 31;
    const float* w = P.ada_w + (size_t)layer * 1024 * 6144 + n0 + col;
    float a0 = 0.f, a1 = 0.f, a2 = 0.f;
#pragma unroll 16
    for (int k = kg * 128; k < kg * 128 + 128; ++k) {
      const float wv = w[(size_t)k * 6144];
      a0 += sc[k] * wv;
      a1 += sc[1024 + k] * wv;
      a2 += sc[2048 + k] * wv;
    }
    red[(kg * 32 + col) * 3 + 0] = a0;
    red[(kg * 32 + col) * 3 + 1] = a1;
    red[(kg * 32 + col) * 3 + 2] = a2;
    __syncthreads();
    if (tid < 96) {
      const int i = tid >> 5, cl = tid & 31;
      float sacc = P.ada_b[layer * 6144 + n0 + cl];
#pragma unroll
      for (int g = 0; g < 8; ++g) sacc += red[(g * 32 + cl) * 3 + i];
      mod[(layer * 3 + i) * 6144 + n0 + cl] = sacc;
    }
  }
  if (blockIdx.x == gridDim.x - 1) {
    float* rope = (float*)(P.ws + OFF_ROPE);
    for (int e = tid; e < 4096; e += 256) {
      const int p = e >> 4, f = e & 15;
      const float freq = powf(10000.0f, -(float)(2 * f) / 32.0f);
      const float ang = (float)p * freq;
      rope[e * 2] = cosf(ang);
      rope[e * 2 + 1] = sinf(ang);
    }
    if (tid < 64) {
      float p0 = P.a_lambda[tid] * P.a_lambda[64 + tid];
      float p1 = P.a_lambda[128 + tid] * P.a_lambda[192 + tid];
      p0 = wave_sum(p0);
      p1 = wave_sum(p1);
      float gq = fabsf(P.a_qn[tid]), gk = fabsf(P.a_kn[tid]);
#pragma unroll
      for (int o = 32; o >= 1; o >>= 1) {
        gq = fmaxf(gq, __shfl_xor(gq, o));
        gk = fmaxf(gk, __shfl_xor(gk, o));
      }
      if (tid == 0) {
        ((float*)(P.ws + OFF_LAM))[0] = expf(p0) - expf(p1) + 0.2f;
        ((float*)(P.ws + OFF_LAM))[1] = 8.0f * gq * gk * LOG2E * 1.001f + 0.01f;
      }
    }
  }
}

__device__ __forceinline__ float dppf8(float x, const int sel) {
  const int xi = __float_as_int(x);
  int r;
  if (sel == 0) r = __builtin_amdgcn_update_dpp(0, xi, 0xB1, 0xF, 0xF, true);
  else if (sel == 1) r = __builtin_amdgcn_update_dpp(0, xi, 0x4E, 0xF, 0xF, true);
  else r = __builtin_amdgcn_update_dpp(0, xi, 0x141, 0xF, 0xF, true);
  return __int_as_float(r);
}
__device__ __forceinline__ void phase_lora_conv(const Params& P) {
  bf16_t* WL = (bf16_t*)(P.ws + OFF_WL);
  if (threadIdx.x < 224) {
    const int cl = threadIdx.x / 28, kg = threadIdx.x - cl * 28;
    for (int cb = blockIdx.x; cb < 64; cb += gridDim.x) {
      const int c = cb * 8 + cl;
      float v[8];
#pragma unroll
      for (int q = 0; q < 8; ++q) {
        const int kk = kg * 8 + q;
        if (kk < 64) v[q] = P.d_w2[(size_t)kk * 512 + c];
        else if (kk < 128) v[q] = P.d_a2[(size_t)(kk - 64) * 512 + c];
        else v[q] = P.d_g2[(size_t)(kk - 128) * 512 + c];
      }
      *(uint4*)(WL + (size_t)c * 224 + kg * 8) = make_uint4(pack2(v[0], v[1]), pack2(v[2], v[3]), pack2(v[4], v[5]), pack2(v[6], v[7]));
    }
  }
}

#define PREP_T 32
#define SLS 232
__device__ __forceinline__ void phase_prep(const Params& P, char* smem) {
  char* ws = P.ws;
  bf16_t* sL = (bf16_t*)smem;
  const bf16_t* RAW = (const bf16_t*)(ws + OFF_RAW);
  const float* LORA = (const float*)(ws + OFF_LORA);
  const bf16_t* WL = (const bf16_t*)(ws + OFF_WL);
  bf16_t* XR = (bf16_t*)(ws + OFF_XR);
  bf16_t* XK = (bf16_t*)(ws + OFF_XK);
  bf16_t* XV = (bf16_t*)(ws + OFF_XV);
  bf16_t* KK = (bf16_t*)(ws + OFF_KK);
  bf16_t* DP = (bf16_t*)(ws + OFF_DP);
  bf16_t* AZ = (bf16_t*)(ws + OFF_AZ);
  bf16_t* Acat = (bf16_t*)(ws + OFF_A);
  const float* mu = P.d_mu;
  const int tid = threadIdx.x, lane = tid & 63, wave = tid >> 6, l15 = lane & 15, quad = lane >> 4;
  for (int tt = blockIdx.x; tt < MROWS / PREP_T; tt += gridDim.x) {
    const int row0 = tt * PREP_T;
    const int b = row0 / TPB, k0 = row0 - b * TPB;
    __syncthreads();
    for (int e = tid; e < PREP_T * 8; e += 256) sL[(e >> 3) * SLS + 224 + (e & 7)] = 0;
#pragma unroll 7
    for (int e = tid; e < PREP_T * 224; e += 256) {
      const int tok = e / 224, j = e - tok * 224;
      const int kidx = k0 + tok, row = row0 + tok;
      const bool hp = (kidx != 0 && kidx != 256), hn = (kidx != 255 && kidx != TPB - 1);
      const float x = LORA[(size_t)row * 224 + j];
      const float xp = hp ? LORA[(size_t)(row - 1) * 224 + j] : 0.f;
      const float xn = hn ? LORA[(size_t)(row + 1) * 224 + j] : 0.f;
      const float xs = x + mu[1536 + j] * (0.5f * (xp + xn) - x);
      sL[tok * SLS + j] = f2bf(j < 64 ? (1.0f - 2.0f * __builtin_amdgcn_rcpf(__expf(2.0f * xs) + 1.0f)) : (j < 128 ? xs : sigmoidf_(xs)));
    }
    __syncthreads();
    for (int nt = 0; nt < 8; ++nt) {
      const int n0 = wave * 128 + nt * 16;
      bf16x8 wf[7];
#pragma unroll
      for (int kb = 0; kb < 7; ++kb) wf[kb] = *(const bf16x8*)(WL + (size_t)(n0 + l15) * 224 + kb * 32 + quad * 8);
      const int c4 = n0 + quad * 4;
      const float4 w00 = *(const float4*)(P.d_w0 + c4), w01 = *(const float4*)(P.d_w0 + 512 + c4);
      const float4 a00 = *(const float4*)(P.d_a0 + c4), a01 = *(const float4*)(P.d_a0 + 512 + c4);
#pragma unroll
      for (int mt = 0; mt < PREP_T / 16; ++mt) {
        bf16x8 af[7];
#pragma unroll
        for (int kb = 0; kb < 7; ++kb) af[kb] = *(const bf16x8*)(sL + (mt * 16 + l15) * SLS + kb * 32 + quad * 8);
        const f32x4 zero = (f32x4){0.f, 0.f, 0.f, 0.f};
        f32x4 aw0 = __builtin_amdgcn_mfma_f32_16x16x32_bf16(wf[0], af[0], zero, 0, 0, 0);
        f32x4 aw1 = __builtin_amdgcn_mfma_f32_16x16x32_bf16(wf[1], af[1], zero, 0, 0, 0);
        f32x4 aa0 = __builtin_amdgcn_mfma_f32_16x16x32_bf16(wf[2], af[2], zero, 0, 0, 0);
        f32x4 aa1 = __builtin_amdgcn_mfma_f32_16x16x32_bf16(wf[3], af[3], zero, 0, 0, 0);
        f32x4 ag = __builtin_amdgcn_mfma_f32_16x16x32_bf16(wf[4], af[4], zero, 0, 0, 0);
        ag = __builtin_amdgcn_mfma_f32_16x16x32_bf16(wf[5], af[5], ag, 0, 0, 0);
        ag = __builtin_amdgcn_mfma_f32_16x16x32_bf16(wf[6], af[6], ag, 0, 0, 0);
        const size_t row = (size_t)(row0 + mt * 16 + l15);
        float dp0[4], dp1[4], az0[4], az1[4];
#pragma unroll
        for (int e = 0; e < 4; ++e) {
          const float wb0 = e == 0 ? w00.x : (e == 1 ? w00.y : (e == 2 ? w00.z : w00.w));
          const float wb1 = e == 0 ? w01.x : (e == 1 ? w01.y : (e == 2 ? w01.z : w01.w));
          const float ab0 = e == 0 ? a00.x : (e == 1 ? a00.y : (e == 2 ? a00.z : a00.w));
          const float ab1 = e == 0 ? a01.x : (e == 1 ? a01.y : (e == 2 ? a01.z : a01.w));
#pragma unroll
          for (int z = 0; z < 2; ++z) {
            const float wv = z == 0 ? wb0 + aw0[e] : wb1 + aw1[e];
            const float ee = 0.60653066f * sigmoidf_(wv);
            const float dpv = 1.0f - __expf(-ee);
            const float av = sigmoidf_(z == 0 ? ab0 + aa0[e] : ab1 + aa1[e]);
            if (z == 0) { dp0[e] = dpv; az0[e] = av; } else { dp1[e] = dpv; az1[e] = av; }
          }
        }
        uint2 w;
        w.x = pack2(dp0[0], dp0[1]); w.y = pack2(dp0[2], dp0[3]);
        *(uint2*)(DP + row * 512 + c4) = w;
        w.x = pack2(dp1[0], dp1[1]); w.y = pack2(dp1[2], dp1[3]);
        *(uint2*)(DP + (SZ512 / 2) + row * 512 + c4) = w;
        w.x = pack2(az0[0], az0[1]); w.y = pack2(az0[2], az0[3]);
        *(uint2*)(AZ + row * 512 + c4) = w;
        w.x = pack2(az1[0], az1[1]); w.y = pack2(az1[2], az1[3]);
        *(uint2*)(AZ + (SZ512 / 2) + row * 512 + c4) = w;
        w.x = pack2(ag[0], ag[1]); w.y = pack2(ag[2], ag[3]);
        *(uint2*)(Acat + row * DM + 512 + c4) = w;
      }
    }
    __syncthreads();
    {
      const int c8 = (tid & 63) * 8, tk = tid >> 6;
      float mr[8], mk[8], mv[8], kc[8];
#pragma unroll
      for (int q = 0; q < 8; ++q) { mr[q] = mu[c8 + q]; mk[q] = mu[512 + c8 + q]; mv[q] = mu[1024 + c8 + q]; kc[q] = P.d_k_k[c8 + q]; }
#pragma unroll 2
      for (int pass = 0; pass < PREP_T / 4; ++pass) {
        const int k = pass * 4 + tk;
        const int kidx = k0 + k;
        const size_t row = (size_t)(row0 + k);
        const bool hp = (kidx != 0 && kidx != 256), hn = (kidx != 255 && kidx != TPB - 1);
        uint4 xc[3], xpv[3], xnv[3];
#pragma unroll
        for (int q = 0; q < 3; ++q) {
          xc[q] = *(const uint4*)(RAW + row * 1536 + q * 512 + c8);
          xpv[q] = hp ? *(const uint4*)(RAW + (row - 1) * 1536 + q * 512 + c8) : make_uint4(0u, 0u, 0u, 0u);
          xnv[q] = hn ? *(const uint4*)(RAW + (row + 1) * 1536 + q * 512 + c8) : make_uint4(0u, 0u, 0u, 0u);
        }
        float xs[3][8];
#pragma unroll
        for (int q = 0; q < 3; ++q) {
          const uint32_t cw[4] = {xc[q].x, xc[q].y, xc[q].z, xc[q].w};
          const uint32_t pw[4] = {xpv[q].x, xpv[q].y, xpv[q].z, xpv[q].w};
          const uint32_t nw[4] = {xnv[q].x, xnv[q].y, xnv[q].z, xnv[q].w};
#pragma unroll
          for (int w = 0; w < 4; ++w) {
            const float x0 = __uint_as_float(cw[w] << 16), x1 = __uint_as_float(cw[w] & 0xffff0000u);
            const float p0 = __uint_as_float(pw[w] << 16), p1 = __uint_as_float(pw[w] & 0xffff0000u);
            const float n0 = __uint_as_float(nw[w] << 16), n1 = __uint_as_float(nw[w] & 0xffff0000u);
            const float m0 = q == 0 ? mr[2 * w] : (q == 1 ? mk[2 * w] : mv[2 * w]);
            const float m1 = q == 0 ? mr[2 * w + 1] : (q == 1 ? mk[2 * w + 1] : mv[2 * w + 1]);
            xs[q][2 * w] = x0 + m0 * (0.5f * (p0 + n0) - x0);
            xs[q][2 * w + 1] = x1 + m1 * (0.5f * (p1 + n1) - x1);
          }
        }
        *(uint4*)(XR + row * 512 + c8) = make_uint4(pack2(xs[0][0], xs[0][1]), pack2(xs[0][2], xs[0][3]), pack2(xs[0][4], xs[0][5]), pack2(xs[0][6], xs[0][7]));
        *(uint4*)(XK + row * 512 + c8) = make_uint4(pack2(xs[1][0], xs[1][1]), pack2(xs[1][2], xs[1][3]), pack2(xs[1][4], xs[1][5]), pack2(xs[1][6], xs[1][7]));
        *(uint4*)(XV + row * 512 + c8) = make_uint4(pack2(xs[2][0], xs[2][1]), pack2(xs[2][2], xs[2][3]), pack2(xs[2][4], xs[2][5]), pack2(xs[2][6], xs[2][7]));
        float kv[8], ss = 0.f;
#pragma unroll
        for (int q = 0; q < 8; ++q) { kv[q] = xs[1][q] * kc[q]; ss += kv[q] * kv[q]; }
        ss += dppf8(ss, 0);
        ss += dppf8(ss, 1);
        ss += dppf8(ss, 2);
        const float inv = 1.0f / fmaxf(sqrtf(ss), 1e-12f);
        *(uint4*)(KK + row * 512 + c8) = make_uint4(pack2(kv[0] * inv, kv[1] * inv), pack2(kv[2] * inv, kv[3] * inv),
                                                   pack2(kv[4] * inv, kv[5] * inv), pack2(kv[6] * inv, kv[7] * inv));
      }
    }
  }
}

__device__ __forceinline__ float dppf(float x, const int ctrl_sel) {
  int xi = __float_as_int(x), r;
  if (ctrl_sel == 0) r = __builtin_amdgcn_update_dpp(0, xi, 0xB1, 0xF, 0xF, true);
  else if (ctrl_sel == 1) r = __builtin_amdgcn_update_dpp(0, xi, 0x4E, 0xF, 0xF, true);
  else if (ctrl_sel == 2) r = __builtin_amdgcn_update_dpp(0, xi, 0x141, 0xF, 0xF, true);
  else r = __builtin_amdgcn_update_dpp(0, xi, 0x140, 0xF, 0xF, true);
  return __int_as_float(r);
}
__device__ __forceinline__ float red16(float x) {
  x += dppf(x, 0);
  x += dppf(x, 1);
  x += dppf(x, 2);
  x += dppf(x, 3);
  return x;
}

__device__ __forceinline__ void phase_scan(const Params& P, char* smem) {
  const int kloc = blockIdx.x >> 3;
  if ((kloc & 1) || kloc >= 32) return;
  const int widx = (kloc >> 1) * 8 + (blockIdx.x & 7);
  char* ws = P.ws;
  const int chain = widx >> 2, rg = widx & 3;
  const int z = chain >> 4, b = (chain >> 3) & 1, h = chain & 7;
  const bf16_t* XR = (const bf16_t*)(ws + OFF_XR);
  const bf16_t* XK = (const bf16_t*)(ws + OFF_XK);
  const bf16_t* XV = (const bf16_t*)(ws + OFF_XV);
  const bf16_t* KK = (const bf16_t*)(ws + OFF_KK);
  const bf16_t* DP = (const bf16_t*)(ws + OFF_DP) + (size_t)z * (SZ512 / 2);
  const bf16_t* AZ = (const bf16_t*)(ws + OFF_AZ) + (size_t)z * (SZ512 / 2);
  bf16_t* YZ = (bf16_t*)(ws + OFF_YZ) + (size_t)z * (SZ512 / 2);
  float* buf = (float*)smem;
  const int tid = threadIdx.x;
  const int rowl = tid >> 4, kq = tid & 15;
  const int vrow = rg * 16 + rowl;
  const int sl = tid >> 4, k4 = (tid & 15) * 4;
  float ka[4];
#pragma unroll
  for (int i = 0; i < 4; ++i) ka[i] = P.d_k_a[h * 64 + k4 + i];
  f32x2 S01 = (f32x2){0.f, 0.f}, S23 = (f32x2){0.f, 0.f};
  uint2 g_r[2], g_k[2], g_v[2], g_kk[2], g_dp[2], g_az[2];
  auto kidx_of = [&](int n) { return z == 0 ? n : (n < 256 ? 255 - n : 16895 - n); };
#define SCAN_GLOAD(ci_)                                                              \
  _Pragma("unroll") for (int hh = 0; hh < 2; ++hh) {                                 \
    const int kidx = kidx_of((ci_) * 32 + hh * 16 + sl);                             \
    const size_t off = (size_t)(b * TPB + kidx) * 512 + h * 64 + k4;                 \
    g_r[hh] = *(const uint2*)(XR + off);                                             \
    g_k[hh] = *(const uint2*)(XK + off);                                             \
    g_v[hh] = *(const uint2*)(XV + off);                                             \
    g_kk[hh] = *(const uint2*)(KK + off);                                            \
    g_dp[hh] = *(const uint2*)(DP + off);                                            \
    g_az[hh] = *(const uint2*)(AZ + off);                                            \
  }
  SCAN_GLOAD(0)
  const int nchunks = TPB / 32;
  for (int ci = 0; ci < nchunks; ++ci) {
#pragma unroll
    for (int hh = 0; hh < 2; ++hh) {
      float r[4], k[4], v[4], kk[4], dp[4], az[4];
      r[0] = __uint_as_float(g_r[hh].x << 16); r[1] = __uint_as_float(g_r[hh].x & 0xffff0000u);
      r[2] = __uint_as_float(g_r[hh].y << 16); r[3] = __uint_as_float(g_r[hh].y & 0xffff0000u);
      k[0] = __uint_as_float(g_k[hh].x << 16); k[1] = __uint_as_float(g_k[hh].x & 0xffff0000u);
      k[2] = __uint_as_float(g_k[hh].y << 16); k[3] = __uint_as_float(g_k[hh].y & 0xffff0000u);
      v[0] = __uint_as_float(g_v[hh].x << 16); v[1] = __uint_as_float(g_v[hh].x & 0xffff0000u);
      v[2] = __uint_as_float(g_v[hh].y << 16); v[3] = __uint_as_float(g_v[hh].y & 0xffff0000u);
      kk[0] = __uint_as_float(g_kk[hh].x << 16); kk[1] = __uint_as_float(g_kk[hh].x & 0xffff0000u);
      kk[2] = __uint_as_float(g_kk[hh].y << 16); kk[3] = __uint_as_float(g_kk[hh].y & 0xffff0000u);
      dp[0] = __uint_as_float(g_dp[hh].x << 16); dp[1] = __uint_as_float(g_dp[hh].x & 0xffff0000u);
      dp[2] = __uint_as_float(g_dp[hh].y << 16); dp[3] = __uint_as_float(g_dp[hh].y & 0xffff0000u);
      az[0] = __uint_as_float(g_az[hh].x << 16); az[1] = __uint_as_float(g_az[hh].x & 0xffff0000u);
      az[2] = __uint_as_float(g_az[hh].y << 16); az[3] = __uint_as_float(g_az[hh].y & 0xffff0000u);
      float* bp = buf + (hh * 16 + sl) * 384 + k4;
      *(float4*)(bp + 0) = make_float4(r[0], r[1], r[2], r[3]);
      *(float4*)(bp + 64) = make_float4(1.f - dp[0], 1.f - dp[1], 1.f - dp[2], 1.f - dp[3]);
      *(float4*)(bp + 128) = make_float4(k[0] * (1.f + (az[0] - 1.f) * ka[0]), k[1] * (1.f + (az[1] - 1.f) * ka[1]),
                                         k[2] * (1.f + (az[2] - 1.f) * ka[2]), k[3] * (1.f + (az[3] - 1.f) * ka[3]));
      *(float4*)(bp + 192) = make_float4(v[0], v[1], v[2], v[3]);
      *(float4*)(bp + 256) = make_float4(-kk[0], -kk[1], -kk[2], -kk[3]);
      *(float4*)(bp + 320) = make_float4(kk[0] * az[0], kk[1] * az[1], kk[2] * az[2], kk[3] * az[3]);
    }
    __syncthreads();
    if (ci + 1 < nchunks) { SCAN_GLOAD(ci + 1) }
    float ykeep0 = 0.f, ykeep1 = 0.f;
    f32x4 Lr[2][2], Lw[2][2], Lk[2][2], La[2][2], Lb[2][2];
    float Lv[2][2];
#define SCAN_LOADB(j_, slot_)                                               \
  _Pragma("unroll") for (int u = 0; u < 2; ++u) {                           \
    const float* bp = buf + ((j_) * 2 + u) * 384 + kq * 4;                  \
    Lr[slot_][u] = *(const f32x4*)(bp + 0);                                 \
    Lw[slot_][u] = *(const f32x4*)(bp + 64);                                \
    Lk[slot_][u] = *(const f32x4*)(bp + 128);                               \
    Lv[slot_][u] = buf[((j_) * 2 + u) * 384 + 192 + vrow];                  \
    La[slot_][u] = *(const f32x4*)(bp + 256);                               \
    Lb[slot_][u] = *(const f32x4*)(bp + 320);                               \
  }
    SCAN_LOADB(0, 0)
    float yprev = 0.f;
#pragma unroll
    for (int j = 0; j < 16; ++j) {
      if (j + 1 < 16) {
        SCAN_LOADB(j + 1, (j + 1) & 1)
      }
      __builtin_amdgcn_sched_barrier(0);
#pragma unroll
      for (int u = 0; u < 2; ++u) {
        const int sl2 = j & 1;
        const int st = j * 2 + u;
        const f32x4 a4 = La[sl2][u], b4 = Lb[sl2][u], w4 = Lw[sl2][u], kd = Lk[sl2][u], r4 = Lr[sl2][u];
        const float vv = Lv[sl2][u];
        f32x2 p = S01 * a4.xy;
        p = S23 * a4.zw + p;
        float sa = p.x + p.y;
        sa += dppf(sa, 0); yprev += dppf(yprev, 0);
        sa += dppf(sa, 1); yprev += dppf(yprev, 1);
        sa += dppf(sa, 2); yprev += dppf(yprev, 2);
        sa += dppf(sa, 3); yprev += dppf(yprev, 3);
        if (st >= 1 && st <= 16) ykeep0 = (kq == st - 1) ? yprev : ykeep0;
        if (st >= 17) ykeep1 = (kq == st - 17) ? yprev : ykeep1;
        const f32x2 sa2 = (f32x2){sa, sa}, vv2 = (f32x2){vv, vv};
        const f32x2 t01 = sa2 * b4.xy + vv2 * kd.xy;
        const f32x2 t23 = sa2 * b4.zw + vv2 * kd.zw;
        S01 = S01 * w4.xy + t01;
        S23 = S23 * w4.zw + t23;
        f32x2 q = S01 * r4.xy;
        q = S23 * r4.zw + q;
        yprev = q.x + q.y;
      }
    }
    yprev = red16(yprev);
    ykeep1 = (kq == 15) ? yprev : ykeep1;
    {
      const int kidx0 = kidx_of(ci * 32 + kq), kidx1 = kidx_of(ci * 32 + 16 + kq);
      YZ[(size_t)(b * TPB + kidx0) * 512 + h * 64 + rg * 16 + rowl] = f2bf(ykeep0);
      YZ[(size_t)(b * TPB + kidx1) * 512 + h * 64 + rg * 16 + rowl] = f2bf(ykeep1);
    }
    __syncthreads();
  }
}

__device__ __forceinline__ float red8(float x) {
  x += dppf8(x, 0);
  x += dppf8(x, 1);
  x += dppf8(x, 2);
  return x;
}
__device__ __forceinline__ void unpack8(const uint4 g, float (&o)[8]) {
  o[0] = __uint_as_float(g.x << 16); o[1] = __uint_as_float(g.x & 0xffff0000u);
  o[2] = __uint_as_float(g.y << 16); o[3] = __uint_as_float(g.y & 0xffff0000u);
  o[4] = __uint_as_float(g.z << 16); o[5] = __uint_as_float(g.z & 0xffff0000u);
  o[6] = __uint_as_float(g.w << 16); o[7] = __uint_as_float(g.w & 0xffff0000u);
}
__device__ __forceinline__ void phase_rwkv_out(const Params& P) {
  char* ws = P.ws;
  const bf16_t* XR = (const bf16_t*)(ws + OFF_XR);
  const bf16_t* XK = (const bf16_t*)(ws + OFF_XK);
  const bf16_t* XV = (const bf16_t*)(ws + OFF_XV);
  const bf16_t* AZ = (const bf16_t*)(ws + OFF_AZ);
  const bf16_t* YZ = (const bf16_t*)(ws + OFF_YZ);
  bf16_t* Acat = (bf16_t*)(ws + OFF_A);
  const int lane = threadIdx.x & 63, wave = threadIdx.x >> 6;
  const int c8 = lane * 8;
  float lw[8], lb[8], kav[8], rkv[8];
#pragma unroll
  for (int q = 0; q < 8; ++q) { lw[q] = P.d_ln_w[c8 + q]; lb[q] = P.d_ln_b[c8 + q]; kav[q] = P.d_k_a[c8 + q]; rkv[q] = P.d_r_k[c8 + q]; }
#pragma unroll 2
  for (int idx = blockIdx.x * 4 + wave; idx < 32768; idx += gridDim.x * 4) {
    const size_t row = (size_t)((idx >> 14) * TPB + 256 + (idx & 16383));
    const size_t off = row * 512 + c8;
    const uint4 u_y0 = *(const uint4*)(YZ + off), u_y1 = *(const uint4*)(YZ + (SZ512 / 2) + off);
    const uint4 u_r = *(const uint4*)(XR + off), u_k = *(const uint4*)(XK + off), u_v = *(const uint4*)(XV + off);
    const uint4 u_a0 = *(const uint4*)(AZ + off), u_a1 = *(const uint4*)(AZ + (SZ512 / 2) + off);
    const uint4 u_g = *(const uint4*)(Acat + row * DM + 512 + c8);
    float y0[8], y1[8], rr[8], kk_[8], vv[8], a0[8], a1[8], gg[8];
    unpack8(u_y0, y0); unpack8(u_y1, y1); unpack8(u_r, rr); unpack8(u_k, kk_); unpack8(u_v, vv);
    unpack8(u_a0, a0); unpack8(u_a1, a1); unpack8(u_g, gg);
    float y[8], sy = 0.f, sd = 0.f;
#pragma unroll
    for (int q = 0; q < 8; ++q) {
      y[q] = y0[q] + y1[q];
      sy += y[q];
      const float kd = kk_[q] * (1.f + (a0[q] - 1.f) * kav[q]) + kk_[q] * (1.f + (a1[q] - 1.f) * kav[q]);
      sd += rr[q] * kd * rkv[q];
    }
    const float mean = red8(sy) * (1.0f / 64.0f);
    const float sdot = red8(sd);
    float sv = 0.f;
#pragma unroll
    for (int q = 0; q < 8; ++q) { y[q] -= mean; sv += y[q] * y[q]; }
    const float rstd = rsqrtf(red8(sv) * (1.0f / 64.0f) + 64e-5f);
    float o[8];
#pragma unroll
    for (int q = 0; q < 8; ++q) o[q] = (y[q] * rstd * lw[q] + lb[q] + sdot * vv[q]) * gg[q];
    *(uint4*)(Acat + row * DM + 512 + c8) = make_uint4(pack2(o[0], o[1]), pack2(o[2], o[3]), pack2(o[4], o[5]), pack2(o[6], o[7]));
  }
}

#define XB_TMO      128
#define XB_XCNT(j)  (256  + 64 * (j))
#define XB_XSUB(j)  (1280 + 64 * (j))
#define XB_XGEN(j)  (2304 + 64 * (j))
#define XB_TOP      3328
#define XB_TOPGEN   3392
#define XCD_BAR_WORDS 3456
#define XB_SPIN_CAP (1u << 22)
#define LAS __attribute__((address_space(3)))
__device__ __forceinline__ unsigned xb_ld(unsigned* p) { return __hip_atomic_load(p, __ATOMIC_RELAXED, __HIP_MEMORY_SCOPE_AGENT); }
__device__ __forceinline__ unsigned xb_add(unsigned* p, unsigned v) { return __hip_atomic_fetch_add(p, v, __ATOMIC_RELAXED, __HIP_MEMORY_SCOPE_AGENT); }
__device__ __forceinline__ unsigned xb_xcc_id() { return (unsigned)__builtin_amdgcn_s_getreg((3 << 11) | 20) & 0xFu; }
#define XB_SPIN(cond, bar) do { unsigned _sp = 0; while (cond) { __builtin_amdgcn_s_sleep(1); \
    if ((++_sp & 255u) == 0u) { if (xb_ld(&(bar)[XB_TMO])) break; if (_sp > XB_SPIN_CAP) { atomicAdd(&(bar)[XB_TMO], 1u); break; } } } } while (0)
struct XcdBarrier { unsigned* bar; unsigned x; volatile LAS unsigned* st; };
__device__ __forceinline__ XcdBarrier xcd_barrier_post(unsigned* bar, volatile LAS unsigned* st) {
  XcdBarrier b; b.bar = bar; b.x = xb_xcc_id(); b.st = st;
  if (threadIdx.x == 0) (void)xb_add(&bar[XB_XCNT(b.x)], 1u);
  return b;
}
__device__ __forceinline__ void xcd_barrier_complete(unsigned* bar, unsigned x, unsigned& nloc, unsigned& nx) {
  const unsigned G = gridDim.x * gridDim.y * gridDim.z;
  unsigned sum, cnt, mine, sp = 0u;
  for (;;) {
    sum = 0u; cnt = 0u; mine = 0u;
#pragma unroll
    for (unsigned j = 0; j < 16; ++j) { const unsigned c = xb_ld(&bar[XB_XCNT(j)]); sum += c; cnt += (c > 0u) ? 1u : 0u; mine = (j == x) ? c : mine; }
    if (sum == G) break;
    __builtin_amdgcn_s_sleep(1);
    if ((++sp & 255u) == 0u) { if (xb_ld(&bar[XB_TMO])) break; if (sp > XB_SPIN_CAP) { atomicAdd(&bar[XB_TMO], 1u); break; } }
  }
  nloc = mine > 0u ? mine : 1u; nx = cnt > 0u ? cnt : 1u;
}
__device__ __forceinline__ void xcd_barrier(const XcdBarrier& b) {
  asm volatile("s_waitcnt vmcnt(0)" ::: "memory");
  __syncthreads();
  if (threadIdx.x == 0) {
    unsigned* bar = b.bar;
    __builtin_amdgcn_s_waitcnt(0);
    unsigned nloc = b.st[0], nx = b.st[1];
    if (nloc == 0u) { xcd_barrier_complete(bar, b.x, nloc, nx); b.st[0] = nloc; b.st[1] = nx; }
    const unsigned old = xb_add(&bar[XB_XSUB(b.x)], 1u);
    const unsigned gen = old / nloc;
    if (old + 1u == (gen + 1u) * nloc) {
      __builtin_amdgcn_fence(__ATOMIC_RELEASE, "agent");
      asm volatile("s_waitcnt vmcnt(0)" ::: "memory");
      const unsigned og = xb_add(&bar[XB_TOP], 1u);
      const unsigned tg = og / nx;
      if (og + 1u == (tg + 1u) * nx) xb_add(&bar[XB_TOPGEN], 1u);
      else XB_SPIN(xb_ld(&bar[XB_TOPGEN]) == tg, bar);
      __builtin_amdgcn_fence(__ATOMIC_ACQUIRE, "agent");
      xb_add(&bar[XB_XGEN(b.x)], 1u);
      asm volatile("s_waitcnt vmcnt(0)" ::: "memory");
    } else {
      XB_SPIN(xb_ld(&bar[XB_XGEN(b.x)]) == gen, bar);
      __builtin_amdgcn_fence(__ATOMIC_ACQUIRE, "agent");
      asm volatile("s_waitcnt vmcnt(0)" ::: "memory");
    }
  }
  __syncthreads();
}

#define NPHASE 18
__device__ __forceinline__ void run_phase(const Params& P, int ph, char* smem) {
  char* ws = P.ws;
  bf16_t* A = (bf16_t*)(ws + OFF_A);
  float* xctx = (float*)(ws + OFF_XCTX);
  const float* mod0 = (const float*)(ws + OFF_MOD);
  const float* mod1 = mod0 + 3 * 6144;
  const bf16_t* WIN = (const bf16_t*)(ws + OFF_WIN);
  const bf16_t* WOUT = (const bf16_t*)(ws + OFF_WOUT);
  const bf16_t* WGU = (const bf16_t*)(ws + OFF_WGU);
  const bf16_t* WDN = (const bf16_t*)(ws + OFF_WDN);
  bf16_t* ACT = (bf16_t*)(ws + OFF_ACT);
  switch (ph) {
    case 0:
      phase_conv(P, 0, smem, 0, blockIdx.x, gridDim.x);
      phase_adaln(P, smem);
      break;
    case 1:
      phase_norm(P.x, P.ctx, P.norm_mix, mod0, 0, 1024, A, false);
      break;
    case 2: {
      EpiIn0 e;
      e.a_qn = P.a_qn; e.a_kn = P.a_kn; e.b_qn = P.b_qn; e.b_kn = P.b_kn;
      e.rope = (const float*)(ws + OFF_ROPE);
      e.AQ = (bf16_t*)(ws + OFF_AQ); e.AK = (bf16_t*)(ws + OFF_AK); e.AVT = (bf16_t*)(ws + OFF_AVT);
      e.BQ = (bf16_t*)(ws + OFF_BQ); e.BK = (bf16_t*)(ws + OFF_BK); e.BVT = (bf16_t*)(ws + OFF_BVT);
      gemm_phase<false>(A, DM, WIN, 1024, 18, false, e, smem);
    } break;
    case 3:
      phase_attn0(P, smem);
      break;
    case 4: {
      EpiRes e;
      e.lat_src = P.x; e.ctx_src = P.ctx; e.lat_dst = P.out; e.ctx_dst = xctx; e.gate = mod0 + 2048;
      gemm_phase<true>(A, DM, WOUT, 1024, 8, false, e, smem);
    } break;
    case 5:
      phase_norm(P.out, xctx, P.norm_ffn, mod0, 3072, 4096, A, false);
      break;
    case 6: {
      EpiGU e;
      e.ACT = ACT;
      gemm_phase<true>(A, DM, WGU, 1024, 44, false, e, smem);
    } break;
    case 7: {
      EpiRes e;
      e.lat_src = P.out; e.ctx_src = xctx; e.lat_dst = P.out; e.ctx_dst = xctx; e.gate = mod0 + 5120;
      gemm_phase<true>(ACT, DFF, WDN, DFF, 8, false, e, smem);
    } break;
    case 8:
      phase_conv(P, 1, smem, 1, blockIdx.x, gridDim.x);
      phase_lora_conv(P);
      phase_norm(P.out, xctx, P.norm_mix + 1024, mod1, 0, 1024, A, false);
      break;
    case 9: {
      EpiIn1 e;
      e.c_qn = P.c_qn; e.c_kn = P.c_kn;
      e.CQ = (bf16_t*)(ws + OFF_CQ); e.CK = (bf16_t*)(ws + OFF_CK); e.CVT = (bf16_t*)(ws + OFF_CVT);
      e.RAW = (bf16_t*)(ws + OFF_RAW); e.LORA = (float*)(ws + OFF_LORA);
      gemm_phase<false>(A, DM, WIN, 1024, 26, false, e, smem);
    } break;
    case 10:
      phase_na(P, smem);
      break;
    case 11:
      phase_prep(P, smem);
      break;
    case 12: {
      const int kloc = blockIdx.x >> 3;
      const bool is_scan = !((kloc & 1) || kloc >= 32);
      if (is_scan) phase_scan(P, smem);
      else {
        const int kc = kloc < 32 ? kloc : 32;
        phase_conv(P, 1, smem, 2, (int)blockIdx.x - 8 * ((kc + 1) >> 1), (int)gridDim.x - 128);
      }
    } break;
    case 13:
      phase_rwkv_out(P);
      break;
    case 14: {
      EpiRes e;
      e.lat_src = P.out; e.ctx_src = xctx; e.lat_dst = P.out; e.ctx_dst = xctx; e.gate = mod1 + 2048;
      gemm_phase<true>(A, DM, WOUT, 1024, 8, true, e, smem);
    } break;
    case 15:
      phase_norm(P.out, xctx, P.norm_ffn + 1024, mod1, 3072, 4096, A, true);
      break;
    case 16: {
      EpiGU e;
      e.ACT = ACT;
      gemm_phase<true>(A, DM, WGU, 1024, 44, true, e, smem);
    } break;
    case 17: {
      EpiRes e;
      e.lat_src = P.out; e.ctx_src = xctx; e.lat_dst = P.out; e.ctx_dst = xctx; e.gate = mod1 + 5120;
      gemm_phase<true>(ACT, DFF, WDN, DFF, 8, true, e, smem);
    } break;
    default: break;
  }
}

#define SMEM_BYTES 49152

#if MEGA
template <int PH>
__device__ __forceinline__ void run_all(const Params& P, char* smem, cg::grid_group& grid, const XcdBarrier& xb) {
  run_phase(P, PH, smem);
  if constexpr (((DUP_MASK >> PH) & 1) != 0) {
    xcd_barrier(xb);
    run_phase(P, PH, smem);
  }
  if constexpr (PH + 1 < NPHASE) {
    if constexpr (PH == 0) grid.sync(); else xcd_barrier(xb);
    run_all<PH + 1>(P, smem, grid, xb);
  }
}
__global__ void __launch_bounds__(256, 2) fwd_mega(Params P) {
  extern __shared__ __attribute__((aligned(16))) char smem[];
  __shared__ uint4 xb_words;
  cg::grid_group grid = cg::this_grid();
  if (threadIdx.x == 0) xb_words = make_uint4(0u, 0u, 0u, 0u);
  __syncthreads();
  XcdBarrier xb = xcd_barrier_post((unsigned*)(P.ws + OFF_BAR), (volatile LAS unsigned*)&xb_words);
  run_all<0>(P, smem, grid, xb);
}
#else
template <int PH>
__global__ void __launch_bounds__(256, 2) fwd_phase(Params P) {
  extern __shared__ __attribute__((aligned(16))) char smem[];
  run_phase(P, PH, smem);
}
template <int PH>
static void launch_all(const Params& P, hipStream_t stream) {
  fwd_phase<PH><<<512, 256, SMEM_BYTES, stream>>>(P);
  if constexpr (PH + 1 < NPHASE) launch_all<PH + 1>(P, stream);
}
#endif

extern "C" void kernel_launch(void* const* d_in, const int* in_sizes, int n_in, void* d_out, int out_size, void* d_ws,
                              size_t ws_size, hipStream_t stream) {
  if (ws_size < WS_NEEDED) {
    fprintf(stderr, "workspace too small: %zu < %llu\n", ws_size, (unsigned long long)WS_NEEDED);
    return;
  }
  Params P{};
  const float** pp = (const float**)&P;
  for (int i = 0; i < 36; ++i) pp[i] = (const float*)d_in[i];
  P.out = (float*)d_out;
  P.ws = (char*)d_ws;
#if MEGA
  static int grid_blocks = 0;
  if (!grid_blocks) {
    int dev = 0, cus = 0, per_cu = 0;
    hipGetDevice(&dev);
    hipDeviceGetAttribute(&cus, hipDeviceAttributeMultiprocessorCount, dev);
    hipFuncSetAttribute((const void*)fwd_mega, hipFuncAttributeMaxDynamicSharedMemorySize, SMEM_BYTES);
    hipOccupancyMaxActiveBlocksPerMultiprocessor(&per_cu, fwd_mega, 256, SMEM_BYTES);
    if (per_cu > 2) per_cu = 2;
    grid_blocks = cus * per_cu;
  }
  hipMemsetAsync((char*)d_ws + OFF_BAR, 0, XCD_BAR_WORDS * sizeof(unsigned), stream);
  void* args[] = {&P};
  hipError_t e = hipLaunchCooperativeKernel((void*)fwd_mega, dim3(grid_blocks), dim3(256), args, SMEM_BYTES, stream);
  if (e != hipSuccess) fprintf(stderr, "cooperative launch failed: %s (grid %d)\n", hipGetErrorString(e), grid_blocks);
#else
  launch_all<0>(P, stream);
#endif
}
```
